# Optimizing an MI355X kernel written in HIP

```python
import jax, jax.numpy as jnp
from jax import lax
import numpy as np

D_MODEL = 2048
BATCH = 4
SEQ = 2048
DEPTH = 2
DEC_BATCH = 128
DEC_SEQ = 8
PAST_LEN = 16384
PAGE_SIZE = 128

N_META = 16
POOL_WIDTH = D_MODEL
POOL_WINDOWS = (2, 4, 8, 16)
N_POOL_GROUPS = len(POOL_WINDOWS)
POOL_GROUP = POOL_WIDTH // N_POOL_GROUPS
POOL_HIST = max(POOL_WINDOWS) - 1
RET_HEADS = 8
RET_QK_DIM = D_MODEL // RET_HEADS
RET_V_DIM = D_MODEL // RET_HEADS
RET_QK_WIDTH = RET_HEADS * RET_QK_DIM
RET_V_WIDTH = RET_HEADS * RET_V_DIM
RET_CHUNK = 128
ROPE_BASE = 10000.0
EPS = 1e-6
IN_SIZES = (POOL_WIDTH, POOL_WIDTH, RET_QK_WIDTH, RET_QK_WIDTH, RET_V_WIDTH, RET_V_WIDTH, D_MODEL, D_MODEL)
IN_OFFSETS = tuple(int(o) for o in np.cumsum(IN_SIZES)[:-1])
N_IN = sum(IN_SIZES)

kernel_name = 'hybrid_pool_retention_step'

F32 = jnp.float32


def rms_norm(x, g):
    xf = x.astype(F32)
    y = xf * lax.rsqrt(jnp.mean(xf * xf, axis=-1, keepdims=True) + EPS)
    return (y * g.astype(F32)).astype(x.dtype)


def head_norm(o):
    mu = jnp.mean(o, axis=-1, keepdims=True)
    oc = o - mu
    return oc * lax.rsqrt(jnp.mean(oc * oc, axis=-1, keepdims=True) + EPS)


def log_decay():
    return jnp.log1p(-jnp.exp2(-5.0 - jnp.arange(RET_HEADS, dtype=F32)))


def rope(t, pos):
    half = t.shape[-1] // 2
    inv_freq = ROPE_BASE ** (-jnp.arange(half, dtype=F32) / half)
    ang = pos[:, None] * inv_freq[None, :]
    cos = jnp.cos(ang)[None, :, None, :]
    sin = jnp.sin(ang)[None, :, None, :]
    t1, t2 = t[..., :half], t[..., half:]
    return jnp.concatenate([t1 * cos - t2 * sin, t2 * cos + t1 * sin], axis=-1)


def retention_chunk(S, q, k, v):
    n = q.shape[1]
    lg = log_decay()
    idx = jnp.arange(n, dtype=F32)
    diff = idx[:, None] - idx[None, :]
    causal = diff >= 0
    decay = jnp.where(causal[None], jnp.exp(jnp.where(causal, diff, 0.0)[None] * lg[:, None, None]), 0.0)
    scores = jnp.einsum('bihd,bjhd->bhij', q, k) * decay[None]
    intra = jnp.einsum('bhij,bjhe->bihe', scores, v)
    q_decay = jnp.exp((idx[:, None] + 1.0) * lg[None, :])
    inter = jnp.einsum('bihd,bhde->bihe', q, S) * q_decay[None, :, :, None]
    k_decay = jnp.exp((n - 1.0 - idx)[:, None] * lg[None, :])
    S_new = S * jnp.exp(n * lg)[None, :, None, None] + jnp.einsum('bjhd,bjhe->bhde', k * k_decay[None, :, :, None], v)
    return S_new, intra + inter


def retention_prompt(q, k, v):
    b, L = q.shape[:2]
    S0 = jnp.zeros((b, RET_HEADS, RET_QK_DIM, RET_V_DIM), F32)
    S1, o_meta = retention_chunk(S0, q[:, :N_META], k[:, :N_META], v[:, :N_META])
    n_chunks = (L - N_META) // RET_CHUNK

    def to_chunks(t):
        return t[:, N_META:].reshape(b, n_chunks, RET_CHUNK, *t.shape[2:]).swapaxes(0, 1)

    def step(S, qkv):
        return retention_chunk(S, *qkv)

    S_fin, o = lax.scan(step, S1, (to_chunks(q), to_chunks(k), to_chunks(v)))
    o = o.swapaxes(0, 1).reshape(b, n_chunks * RET_CHUNK, RET_HEADS, RET_V_DIM)
    return S_fin, jnp.concatenate([o_meta, o], axis=1)


def pool_mix(u, hist, pos0, pool_w, pool_scale):
    b, n = u.shape[:2]
    uf = u.astype(F32)
    ext = jnp.concatenate([hist.astype(F32), uf], axis=1)
    cs = jnp.concatenate([jnp.zeros_like(ext[:, :1]), jnp.cumsum(ext, axis=1)], axis=1)
    avail = pos0 + jnp.arange(n, dtype=F32) + 1.0
    groups = []
    for g, w in enumerate(POOL_WINDOWS):
        sl = slice(g * POOL_GROUP, (g + 1) * POOL_GROUP)
        wsum = cs[:, POOL_HIST + 1:POOL_HIST + 1 + n, sl] - cs[:, POOL_HIST + 1 - w:POOL_HIST + 1 - w + n, sl]
        cnt = jnp.minimum(float(w), avail)
        groups.append(wsum / cnt[None, :, None])
    pooled = jnp.concatenate(groups, axis=-1) - uf
    mixed = jnp.einsum('bngc,gcd->bngd', pooled.reshape(b, n, N_POOL_GROUPS, POOL_GROUP), pool_w.astype(F32))
    out = mixed.reshape(b, n, POOL_WIDTH) * pool_scale.astype(F32)
    return out.astype(u.dtype), ext[:, -POOL_HIST:].astype(hist.dtype)


def mixer_layer(x, pos, pos0, pool_hist, ret_state, is_prompt, norm_g, w_in, pool_w, pool_scale,
                ret_gn, proj_pool, proj_ret, w_out):
    b, n = x.shape[:2]
    h = rms_norm(x, norm_g)
    z = h @ w_in
    u, pg, q, k, v, rg, gp, gr = jnp.split(z, IN_OFFSETS, axis=-1)
    pool_out, new_hist = pool_mix(u, pool_hist, pos0, pool_w, pool_scale)
    pool_branch = (pool_out * jax.nn.silu(pg)) @ proj_pool
    qh = rope(q.reshape(b, n, RET_HEADS, RET_QK_DIM).astype(F32), pos)
    kh = rope(k.reshape(b, n, RET_HEADS, RET_QK_DIM).astype(F32), pos) * (RET_QK_DIM ** -0.5)
    vh = v.reshape(b, n, RET_HEADS, RET_V_DIM).astype(F32)
    if is_prompt:
        S_new, o = retention_prompt(qh, kh, vh)
    else:
        S_new, o = retention_chunk(ret_state.astype(F32), qh, kh, vh)
    o = head_norm(o).reshape(b, n, RET_V_WIDTH) * ret_gn.astype(F32)
    ret_branch = (o.astype(x.dtype) * jax.nn.silu(rg)) @ proj_ret
    merged = jax.nn.sigmoid(gp) * pool_branch + jax.nn.sigmoid(gr) * ret_branch
    return x + merged @ w_out, new_hist, S_new


def setup_inputs(seed: int = 0) -> dict:
    key = jax.random.key(seed)
    ks = jax.random.split(key, 14)

    def nrm(k, shape, scale):
        return jax.random.normal(k, shape, F32) * scale

    gam = 1.0 - 2.0 ** (-5.0 - np.arange(RET_HEADS))
    ret_scale = jnp.asarray((RET_QK_DIM ** -0.5) / np.sqrt(1.0 - gam ** 2), F32)
    state_ret = nrm(ks[3], (DEPTH, DEC_BATCH, RET_HEADS, RET_QK_DIM, RET_V_DIM), 1.0) * ret_scale[None, None, :, None, None]
    return {
        'x_prompt': nrm(ks[0], (BATCH, SEQ, D_MODEL), 1.0),
        'x_sample': nrm(ks[1], (DEC_BATCH, DEC_SEQ, D_MODEL), 1.0),
        'state_pool': nrm(ks[2], (DEPTH, DEC_BATCH, POOL_HIST, POOL_WIDTH), 1.0),
        'state_ret': state_ret,
        'meta_tokens': nrm(ks[4], (N_META, D_MODEL), 1.0),
        'norm_gain': 1.0 + nrm(ks[5], (DEPTH, D_MODEL), 0.02),
        'w_in': nrm(ks[6], (DEPTH, D_MODEL, N_IN), D_MODEL ** -0.5),
        'pool_w': nrm(ks[7], (DEPTH, N_POOL_GROUPS, POOL_GROUP, POOL_GROUP), POOL_GROUP ** -0.5),
        'pool_scale': 1.0 + nrm(ks[8], (DEPTH, POOL_WIDTH), 0.02),
        'ret_gn_gain': 1.0 + nrm(ks[9], (DEPTH, RET_V_WIDTH), 0.02),
        'proj_pool': nrm(ks[10], (DEPTH, POOL_WIDTH, D_MODEL), POOL_WIDTH ** -0.5),
        'proj_ret': nrm(ks[11], (DEPTH, RET_V_WIDTH, D_MODEL), RET_V_WIDTH ** -0.5),
        'w_out': nrm(ks[12], (DEPTH, D_MODEL, D_MODEL), D_MODEL ** -0.5),
        'final_norm': 1.0 + nrm(ks[13], (D_MODEL,), 0.02),
    }


def reference(x_prompt, x_sample, state_pool, state_ret, meta_tokens, norm_gain, w_in, pool_w,
              pool_scale, ret_gn_gain, proj_pool, proj_ret, w_out, final_norm):
    b = x_prompt.shape[0]
    meta = jnp.broadcast_to(meta_tokens.astype(x_prompt.dtype)[None], (b, N_META, D_MODEL))
    xp = jnp.concatenate([meta, x_prompt], axis=1)
    pos_p = jnp.arange(xp.shape[1], dtype=F32)
    zero_hist = jnp.zeros((b, POOL_HIST, POOL_WIDTH), x_prompt.dtype)
    xs = x_sample
    pos_s = PAST_LEN + jnp.arange(x_sample.shape[1], dtype=F32)
    pool_p, ret_p, pool_s, ret_s = [], [], [], []
    for l in range(DEPTH):
        xp, hp, Sp = mixer_layer(xp, pos_p, 0, zero_hist, None, True, norm_gain[l], w_in[l], pool_w[l],
                                 pool_scale[l], ret_gn_gain[l], proj_pool[l], proj_ret[l], w_out[l])
        xs, hs, Ss = mixer_layer(xs, pos_s, PAST_LEN, state_pool[l], state_ret[l], False, norm_gain[l], w_in[l],
                                 pool_w[l], pool_scale[l], ret_gn_gain[l], proj_pool[l], proj_ret[l], w_out[l])
        pool_p.append(hp)
        ret_p.append(Sp.astype(x_prompt.dtype))
        pool_s.append(hs)
        ret_s.append(Ss.astype(state_ret.dtype))
    y_prompt = rms_norm(xp, final_norm)[:, N_META:]
    y_sample = rms_norm(xs, final_norm)
    new_pool_prompt = jnp.stack(pool_p)
    new_ret_prompt = jnp.stack(ret_p)
    new_pool_sample = jnp.stack(pool_s)
    new_ret_sample = jnp.stack(ret_s)
    return (y_prompt, y_sample, new_pool_prompt, new_ret_prompt, new_pool_sample, new_ret_sample)
```

```cpp
#include <hip/hip_runtime.h>
#include <hip/hip_cooperative_groups.h>
#include <cstdio>
namespace cg = cooperative_groups;

#ifndef MULTI
#define MULTI 0
#endif

#define LAS __attribute__((address_space(3)))
typedef unsigned short bf16_t;
typedef short bf16x8 __attribute__((ext_vector_type(8)));
typedef short s16x4 __attribute__((ext_vector_type(4)));
typedef float f32x4 __attribute__((ext_vector_type(4)));
typedef unsigned u32x4 __attribute__((ext_vector_type(4)));
typedef unsigned u32x2 __attribute__((ext_vector_type(2)));

constexpr int D = 2048, NIN = 16384, ZW = 14336;
constexpr int MS = 1024, LP = 2064, MR = 9280, MPAD = 9472, NMT = 37;
constexpr int NPOS = 2072;
constexpr int LDS_BYTES = 147456;
constexpr float EPS = 1e-6f;
constexpr int ZC_PG = 0, ZC_Q = 2048, ZC_K = 4096, ZC_V = 6144, ZC_RG = 8192, ZC_GP = 10240, ZC_GR = 12288;
constexpr size_t SZ_WIN = (size_t)NIN * D * 2, SZ_WPOOL = (size_t)2048 * 512 * 2, SZ_WPR = (size_t)4096 * D * 2, SZ_WOUT = (size_t)D * D * 2;
constexpr size_t OFF_WIN = 0;
constexpr size_t OFF_WPOOL = OFF_WIN + 2 * SZ_WIN;
constexpr size_t OFF_WPR = OFF_WPOOL + 2 * SZ_WPOOL;
constexpr size_t OFF_WOUT = OFF_WPR + 2 * SZ_WPR;
constexpr size_t OFF_XF = OFF_WOUT + 2 * SZ_WOUT;
constexpr size_t OFF_XB = OFF_XF + (size_t)MPAD * D * 4;
constexpr size_t OFF_RSQ = OFF_XB + (size_t)MPAD * D * 2;
constexpr size_t OFF_U = OFF_RSQ + (size_t)MPAD * 32 * 4;
constexpr size_t OFF_ZB = OFF_U + (size_t)MPAD * D * 4;
constexpr size_t OFF_POOLED = OFF_ZB + (size_t)MPAD * ZW * 2;
constexpr size_t OFF_AIN = OFF_POOLED + (size_t)MPAD * D * 2;
constexpr size_t OFF_M1 = OFF_AIN + (size_t)2 * MPAD * D * 2;
constexpr size_t OFF_MERGED = OFF_M1 + (size_t)MPAD * D * 4;
constexpr size_t OFF_KV = OFF_MERGED + (size_t)MPAD * D * 2;
constexpr size_t OFF_SB = OFF_KV + (size_t)544 * 65536 * 4;
constexpr size_t OFF_CS = OFF_SB + (size_t)544 * 65536 * 2;
constexpr size_t OFF_BAR = OFF_CS + (size_t)NPOS * 128 * 8;
constexpr size_t WS_TOTAL = OFF_BAR + 16384 + 32768;
constexpr int LDS_ST_OFF = 147440;
constexpr size_t O_YP = 0, O_YS = 16777216, O_PP = O_YS + 2097152, O_RP = O_PP + 245760, O_PS = O_RP + 4194304, O_RS = O_PS + 7864320;

struct Params {
    const float *x_prompt, *x_sample, *state_pool, *state_ret, *meta, *norm_gain, *w_in, *pool_w, *pool_scale, *ret_gn, *proj_pool, *proj_ret, *w_out, *final_norm;
    float* out;
    char* ws;
};

__device__ __forceinline__ char* pws(const Params& p) { return p.ws; }
__device__ __forceinline__ float* pout(const Params& p) { return p.out; }
__device__ __forceinline__ unsigned pk_bf16(float lo, float hi) { unsigned r; asm volatile("v_cvt_pk_bf16_f32 %0, %1, %2" : "=v"(r) : "v"(lo), "v"(hi)); return r; }
__device__ __forceinline__ float bf_lo(unsigned u) { return __uint_as_float(u << 16); }
__device__ __forceinline__ float bf_hi(unsigned u) { return __uint_as_float(u & 0xffff0000u); }
__device__ __forceinline__ float dpp_f(float v, const int ctrl_sel) {
    const int x = __builtin_bit_cast(int, v); int r;
    if (ctrl_sel == 0) r = __builtin_amdgcn_update_dpp(0, x, 0xB1, 0xF, 0xF, true);
    else if (ctrl_sel == 1) r = __builtin_amdgcn_update_dpp(0, x, 0x4E, 0xF, 0xF, true);
    else if (ctrl_sel == 2) r = __builtin_amdgcn_update_dpp(0, x, 0x141, 0xF, 0xF, true);
    else r = __builtin_amdgcn_update_dpp(0, x, 0x140, 0xF, 0xF, true);
    return __builtin_bit_cast(float, r);
}
__device__ __forceinline__ float wave_sum(float v) {
    v += dpp_f(v, 0); v += dpp_f(v, 1); v += dpp_f(v, 2); v += dpp_f(v, 3);
    const int x = __builtin_bit_cast(int, v);
    const float a = __builtin_bit_cast(float, __builtin_amdgcn_readlane(x, 0)), b = __builtin_bit_cast(float, __builtin_amdgcn_readlane(x, 16));
    const float c = __builtin_bit_cast(float, __builtin_amdgcn_readlane(x, 32)), d = __builtin_bit_cast(float, __builtin_amdgcn_readlane(x, 48));
    return (a + b) + (c + d);
}
__device__ __forceinline__ void store_wt(f32x4* p, f32x4 v) { asm volatile("global_store_dwordx4 %0, %1, off sc0 sc1" :: "v"(p), "v"(v) : "memory"); }
__device__ __forceinline__ int launder(int v) { asm volatile("" : "+v"(v)); return v; }
__device__ __forceinline__ float lg2gamma(int h) { return log1pf(-exp2f(-5.0f - (float)h)) * 1.4426950408889634f; }
__device__ __forceinline__ float sigmoidf_(float x) { return __builtin_amdgcn_rcpf(1.0f + __expf(-x)); }
__device__ __forceinline__ float siluf_(float x) { return x * sigmoidf_(x); }

constexpr int BM = 256, BK = 64, HALF = 128, HTB = HALF * BK * 2, NXCD = 8, WGM = 8;
__device__ __forceinline__ int lds_byte(int r, int c) { const int st = (r >> 4) * 2 + (c >> 5), rr = r & 15, cc = c & 31, ob = rr * 64 + cc * 2; return st * 1024 + (ob ^ (((ob >> 9) & 1) << 5)); }
__device__ __forceinline__ void stage_rc(int b, int& R, int& C) { const int st = b / 1024, sb = b % 1024, swz = sb ^ (((sb >> 9) & 1) << 5); R = (st >> 1) * 16 + swz / 64; C = (st & 1) * 32 + (swz % 64) / 2; }
__device__ __forceinline__ int perm32(int rho) { const int n = rho >> 4, i = rho & 15; return 8 * (i >> 2) + 4 * n + (i & 3); }

struct Unit { int pm, pn, mode; };
struct StaticOrder {
    int nM, nN, nwg, G, c;
    __device__ void init(int M, int N, int G_, int c_) { nM = M / BM; nN = N / BM; nwg = nM * nN; G = G_; c = c_; }
    __device__ bool next(int i, Unit& u) const {
        const long L = (long)i * G + c; if (L >= nwg) return false;
        int wgid = (int)L; { const int q = nwg / NXCD, r = nwg % NXCD, xcd = wgid % NXCD, off = wgid / NXCD; wgid = (xcd < r ? xcd * (q + 1) : r * (q + 1) + (xcd - r) * q) + off; }
        const int nig = WGM * nN, gid = wgid / nig, fm = gid * WGM, gsz = (nM - fm) < WGM ? (nM - fm) : WGM;
        u.pm = fm + ((wgid % nig) % gsz); u.pn = (wgid % nig) / gsz; u.mode = 0; return true;
    }
};

template <class Epi, class Sched>
__device__ __forceinline__ void gemm_phase(LAS unsigned char* lds, const Sched& S, const Epi& E, const int K, const int lda, const int ldb, const int tid) {
    const int wid = __builtin_amdgcn_readfirstlane(tid >> 6), lane = tid & 63, wr = wid >> 2, wc = wid & 3, fr = lane & 15, fq = lane >> 4;
    const int nt = K / BK;
    unsigned voffA[2], voffB[2];
#pragma unroll
    for (int i = 0; i < 2; ++i) { int R, C; stage_rc(tid * 16 + i * 8192, R, C); const int Rb = (R & ~31) + perm32(R & 31);
        voffA[i] = (unsigned)(R * lda + C) * 2u; voffB[i] = (unsigned)(Rb * ldb + C) * 2u; }
    const size_t kstep = (size_t)(BK * 2);
    const size_t hstepA = (size_t)HALF * lda * 2, hstepB = (size_t)HALF * ldb * 2;
    const unsigned ldsw = (unsigned)wid * 1024u;
    const int aoff = lds_byte(wr * 64 + fr, fq * 8), boff = lds_byte(wc * 32 + fr, fq * 8);
#define G_SA(b, h) (((b) * 2 + (h)) * HTB)
#define G_SB(b, h) ((4 + (b) * 2 + (h)) * HTB)
#define G_STAGE(bufoff, gbase, voff) do { _Pragma("unroll") for (int _i = 0; _i < 2; ++_i) \
        __builtin_amdgcn_global_load_lds((const unsigned*)((const char*)(gbase) + (voff)[_i]), (LAS unsigned*)(lds + (bufoff) + ldsw + _i * 8192), 16, 0, 0); } while (0)
#define G_LDA(dst, b, h) do { _Pragma("unroll") for (int m = 0; m < 4; ++m) _Pragma("unroll") for (int k = 0; k < 2; ++k) dst[m][k] = *(const LAS bf16x8*)(lds + G_SA(b, h) + aoff + m * 2048 + k * 1024); } while (0)
#define G_LDB(dst, b, h) do { _Pragma("unroll") for (int n = 0; n < 2; ++n) _Pragma("unroll") for (int k = 0; k < 2; ++k) dst[n][k] = *(const LAS bf16x8*)(lds + G_SB(b, h) + boff + n * 2048 + k * 1024); } while (0)
#define G_MMA(ai, bj, At, Bt) do { __builtin_amdgcn_s_setprio(1); _Pragma("unroll") for (int m = 0; m < 4; ++m) _Pragma("unroll") for (int n = 0; n < 2; ++n) _Pragma("unroll") for (int k = 0; k < 2; ++k) \
        acc[ai][bj][m][n] = __builtin_amdgcn_mfma_f32_16x16x32_bf16(Bt[n][k], At[m][k], acc[ai][bj][m][n], 0, 0, 0); __builtin_amdgcn_s_setprio(0); } while (0)
#define G_WAIT_V(n) asm volatile("s_waitcnt vmcnt(" #n ")" ::: "memory")
#define G_WAIT_L(n) asm volatile("s_waitcnt lgkmcnt(" #n ")" ::: "memory")
#define G_BAR __builtin_amdgcn_s_barrier()
#define G_SCHED __builtin_amdgcn_sched_barrier(0)
    Unit cur, nxt; int ui = 0;
    if (!S.next(0, cur)) return;
    f32x4 acc[2][2][4][2];
#pragma unroll
    for (int a = 0; a < 2; ++a)
#pragma unroll
        for (int b = 0; b < 2; ++b)
#pragma unroll
            for (int m = 0; m < 4; ++m)
#pragma unroll
                for (int n = 0; n < 2; ++n) acc[a][b][m][n] = (f32x4){0.f, 0.f, 0.f, 0.f};
    bf16x8 At[4][2], B0[2][2], B1[2][2];
    const char* cA; const char* cB; S.ptrs(cur, cA, cB);
    G_STAGE(G_SB(0, 0), cB, voffB); G_STAGE(G_SA(0, 0), cA, voffA); G_STAGE(G_SB(0, 1), cB + hstepB, voffB); G_STAGE(G_SA(0, 1), cA + hstepA, voffA);
    if (wr == 1) G_BAR;
    G_WAIT_V(4); G_BAR;
    G_STAGE(G_SB(1, 0), cB + kstep, voffB); G_STAGE(G_SA(1, 0), cA + kstep, voffA); G_STAGE(G_SB(1, 1), cB + hstepB + kstep, voffB);
    G_WAIT_V(6); G_BAR;
    for (;;) {
        const bool has_next = S.next(ui + 1, nxt);
        const char* nA = cA; const char* nB = cB; if (has_next) S.ptrs(nxt, nA, nB);
        for (int t = 0; t < nt; t += 2) {
            const bool last = (t == nt - 2);
            const char* a1 = cA + (size_t)(t + 1) * kstep;
            const char* a2 = last ? nA : cA + (size_t)(t + 2) * kstep; const char* b2 = last ? nB : cB + (size_t)(t + 2) * kstep;
            const char* a3 = a2 + kstep; const char* b3 = b2 + kstep;
            G_LDB(B0, 0, 0); G_SCHED; G_LDA(At, 0, 0); G_STAGE(G_SA(1, 1), a1 + hstepA, voffA);
            G_WAIT_L(8); G_BAR; G_WAIT_L(0); G_MMA(0, 0, At, B0); G_BAR; G_SCHED;
            G_LDB(B1, 0, 1); G_STAGE(G_SB(0, 0), b2, voffB);
            G_BAR; G_WAIT_L(0); G_MMA(0, 1, At, B1); G_BAR;
            G_LDA(At, 0, 1); G_STAGE(G_SA(0, 0), a2, voffA);
            G_BAR; G_WAIT_L(0); G_MMA(1, 0, At, B0); G_BAR; G_SCHED;
            G_STAGE(G_SB(0, 1), b2 + hstepB, voffB);
            G_WAIT_V(6); G_BAR; G_MMA(1, 1, At, B1); G_BAR;
            G_LDB(B0, 1, 0); G_SCHED; G_LDA(At, 1, 0); G_STAGE(G_SA(0, 1), a2 + hstepA, voffA);
            G_WAIT_L(8); G_BAR; G_WAIT_L(0); G_MMA(0, 0, At, B0); G_BAR; G_SCHED;
            G_LDB(B1, 1, 1); G_STAGE(G_SB(1, 0), b3, voffB);
            G_BAR; G_WAIT_L(0); G_MMA(0, 1, At, B1); G_BAR;
            G_LDA(At, 1, 1); G_STAGE(G_SA(1, 0), a3, voffA);
            G_BAR; G_WAIT_L(0); G_MMA(1, 0, At, B0); G_BAR; G_SCHED;
            G_STAGE(G_SB(1, 1), b3 + hstepB, voffB);
            G_WAIT_V(6); G_BAR; G_MMA(1, 1, At, B1); G_BAR;
        }
        const bool keep = E(acc, cur, wr, wc, fr, fq);
        if (!has_next) break;
        if (!keep)
#pragma unroll
        for (int a = 0; a < 2; ++a)
#pragma unroll
            for (int b = 0; b < 2; ++b)
#pragma unroll
                for (int m = 0; m < 4; ++m)
#pragma unroll
                    for (int n = 0; n < 2; ++n) acc[a][b][m][n] = (f32x4){0.f, 0.f, 0.f, 0.f};
        cur = nxt; cA = nA; cB = nB; ++ui;
    }
    G_WAIT_V(0);
    if (wr == 0) G_BAR;
    G_BAR;
#undef G_SA
#undef G_SB
#undef G_STAGE
#undef G_LDA
#undef G_LDB
#undef G_MMA
#undef G_WAIT_V
#undef G_WAIT_L
#undef G_BAR
#undef G_SCHED
}

struct SchedPlain : StaticOrder {
    const char* A; const char* Bt; size_t tstepA, tstepB;
    __device__ __forceinline__ void ptrs(const Unit& u, const char*& a, const char*& b) const { a = A + (size_t)u.pm * tstepA; b = Bt + (size_t)u.pn * tstepB; }
};
struct SchedPool : StaticOrder {
    const char* A; const char* Bt;
    __device__ __forceinline__ void ptrs(const Unit& u, const char*& a, const char*& b) const {
        a = A + ((size_t)u.pm * 256 * D + (size_t)(u.pn >> 1) * 512) * 2; b = Bt + (size_t)u.pn * 256 * 512 * 2; }
};
struct SchedDual : StaticOrder {
    const char* A; const char* Bt;
    __device__ bool next(int i, Unit& u) const {
        if (i < 2) { if (!StaticOrder::next(0, u)) return false; u.mode = i; return true; }
        if (i == 2 && c < 80) { StaticOrder t = *this; t.c = c < 40 ? c : c - 40; if (!t.next(1, u)) return false; u.mode = c < 40 ? 2 : 3; return true; }
        return false;
    }
    __device__ __forceinline__ void ptrs(const Unit& u, const char*& a, const char*& b) const {
        a = A + (size_t)((u.mode & 1) * NMT + u.pm) * 256 * D * 2; b = Bt + (size_t)((u.mode & 1) * 8 + u.pn) * 256 * D * 2; }
};

struct EpiWin {
    float* u; bf16_t* zb; const float* rsq; const float* cf;
    template <int KIND>
    __device__ __forceinline__ void body(f32x4 (&acc)[2][2][4][2], const Unit& un, int wr, int wc, int fr, int fq) const {
        const int sec = un.pn >> 3, colt = (un.pn & 7) * 256, cw = wc * 32 + 8 * fq;
        const int rbase = un.pm * 256 + wr * 64 + fr;
        float rstd[8];
#pragma unroll
        for (int i = 0; i < 8; ++i) rstd[i] = rsq[rbase + (i >> 2) * 128 + (i & 3) * 16];
        f32x4 cfv[4];
        if (KIND == 2 || KIND == 3) {
#pragma unroll
            for (int t = 0; t < 4; ++t) cfv[t] = *(const f32x4*)(cf + (size_t)cw * 2 + t * 4);
        }
#pragma unroll
        for (int i = 0; i < 8; ++i) rstd[i] = rsqrtf(rstd[i] * (1.0f / 2048.0f) + EPS);
#pragma unroll
        for (int ai = 0; ai < 2; ++ai)
#pragma unroll
            for (int m = 0; m < 4; ++m) {
                const int r = rbase + ai * 128 + m * 16;
                const float rs = rstd[ai * 4 + m];
                f32x4 v[2][2];
#pragma unroll
                for (int bj = 0; bj < 2; ++bj)
#pragma unroll
                    for (int n = 0; n < 2; ++n) v[bj][n] = acc[ai][bj][m][n] * rs;
                if (KIND == 0) {
                    float* up = u + (size_t)r * D + colt + cw;
#pragma unroll
                    for (int bj = 0; bj < 2; ++bj)
#pragma unroll
                        for (int n = 0; n < 2; ++n) *(f32x4*)(up + bj * 128 + 4 * n) = v[bj][n];
                } else {
                    if (KIND == 2 || KIND == 3) {
                        const float pos = r < MS ? (float)(16384 + (r & 7)) : (float)((r - MS) % LP);
                        const float sc = KIND == 3 ? 0.0625f : 1.0f;
#pragma unroll
                        for (int n = 0; n < 2; ++n)
#pragma unroll
                            for (int j = 0; j < 4; ++j) {
                                const int t = 4 * n + j; const float chi = cfv[t >> 1][(t & 1) * 2], clo = cfv[t >> 1][(t & 1) * 2 + 1];
                                const float pp = pos * chi, ee = fmaf(pos, chi, -pp);
                                const float rev = (pp - rintf(pp)) + fmaf(pos, clo, ee);
                                const float cc = __builtin_amdgcn_cosf(rev) * sc, ss = __builtin_amdgcn_sinf(rev) * sc;
                                const float t1 = v[0][n][j], t2 = v[1][n][j];
                                v[0][n][j] = t1 * cc - t2 * ss; v[1][n][j] = t2 * cc + t1 * ss; }
                    } else if (KIND == 1) {
#pragma unroll
                        for (int bj = 0; bj < 2; ++bj)
#pragma unroll
                            for (int n = 0; n < 2; ++n)
#pragma unroll
                                for (int j = 0; j < 4; ++j) v[bj][n][j] = siluf_(v[bj][n][j]);
                    } else if (KIND == 5) {
#pragma unroll
                        for (int bj = 0; bj < 2; ++bj)
#pragma unroll
                            for (int n = 0; n < 2; ++n)
#pragma unroll
                                for (int j = 0; j < 4; ++j) v[bj][n][j] = sigmoidf_(v[bj][n][j]);
                    }
                    bf16_t* zp = zb + (size_t)r * ZW + (size_t)(sec - 1) * 2048 + colt + cw;
#pragma unroll
                    for (int bj = 0; bj < 2; ++bj) { u32x4 w; w.x = pk_bf16(v[bj][0][0], v[bj][0][1]); w.y = pk_bf16(v[bj][0][2], v[bj][0][3]); w.z = pk_bf16(v[bj][1][0], v[bj][1][1]); w.w = pk_bf16(v[bj][1][2], v[bj][1][3]);
                        *(u32x4*)(zp + bj * 128) = w; }
                }
            }
    }
    __device__ __forceinline__ bool operator()(f32x4 (&acc)[2][2][4][2], const Unit& un, int wr, int wc, int fr, int fq) const {
        const int sec = un.pn >> 3;
        if (sec == 0) body<0>(acc, un, wr, wc, fr, fq);
        else if (sec == 1 || sec == 5) body<1>(acc, un, wr, wc, fr, fq);
        else if (sec == 2) body<2>(acc, un, wr, wc, fr, fq);
        else if (sec == 3) body<3>(acc, un, wr, wc, fr, fq);
        else if (sec == 4) body<4>(acc, un, wr, wc, fr, fq);
        else body<5>(acc, un, wr, wc, fr, fq);
        return false;
    }
};

struct EpiPool {
    bf16_t* ain; const bf16_t* zb;
    __device__ __forceinline__ bool operator()(f32x4 (&acc)[2][2][4][2], const Unit& un, int wr, int wc, int fr, int fq) const {
        const int c0 = un.pn * 256 + wc * 32 + 8 * fq;
        const int rbase = un.pm * 256 + wr * 64 + fr;
        u32x4 g[2][4][2];
#pragma unroll
        for (int ai = 0; ai < 2; ++ai)
#pragma unroll
            for (int m = 0; m < 4; ++m)
#pragma unroll
                for (int bj = 0; bj < 2; ++bj) g[ai][m][bj] = *(const u32x4*)(zb + (size_t)(rbase + ai * 128 + m * 16) * ZW + ZC_PG + c0 + bj * 128);
#pragma unroll
        for (int ai = 0; ai < 2; ++ai)
#pragma unroll
            for (int m = 0; m < 4; ++m) {
                const int r = rbase + ai * 128 + m * 16;
#pragma unroll
                for (int bj = 0; bj < 2; ++bj) {
                    const u32x4 gg = g[ai][m][bj];
                    const f32x4 v0 = acc[ai][bj][m][0], v1 = acc[ai][bj][m][1];
                    u32x4 w;
                    w.x = pk_bf16(v0[0] * bf_lo(gg.x), v0[1] * bf_hi(gg.x)); w.y = pk_bf16(v0[2] * bf_lo(gg.y), v0[3] * bf_hi(gg.y));
                    w.z = pk_bf16(v1[0] * bf_lo(gg.z), v1[1] * bf_hi(gg.z)); w.w = pk_bf16(v1[2] * bf_lo(gg.w), v1[3] * bf_hi(gg.w));
                    *(u32x4*)(ain + (size_t)r * D + c0 + bj * 128) = w;
                }
            }
        return false;
    }
};

struct EpiDual {
    bf16_t* merged; const bf16_t* zb; float* m1; unsigned* flag;
    __device__ __forceinline__ bool operator()(f32x4 (&acc)[2][2][4][2], const Unit& un, int wr, int wc, int fr, int fq) const {
        const int mode = un.mode;
        const int c0 = un.pn * 256 + wc * 32 + 8 * fq;
        const int rbase = un.pm * 256 + wr * 64 + fr;
        float* m1w = m1 + (size_t)(wr * 4 + wc) * 128 * 64 + launder(fq * 16 + fr);
        if (!(mode & 1)) {
#pragma unroll
            for (int ai = 0; ai < 2; ++ai)
#pragma unroll
            for (int mh = 0; mh < 2; ++mh) {
                u32x4 gp[2][2], gr[2][2];
#pragma unroll
                for (int m = 0; m < 2; ++m)
#pragma unroll
                    for (int bj = 0; bj < 2; ++bj) { const bf16_t* zp = zb + (size_t)(rbase + ai * 128 + (mh * 2 + m) * 16) * ZW + c0 + bj * 128;
                        gp[m][bj] = *(const u32x4*)(zp + ZC_GP); gr[m][bj] = *(const u32x4*)(zp + ZC_GR); }
#pragma unroll
                for (int m = 0; m < 2; ++m)
#pragma unroll
                    for (int bj = 0; bj < 2; ++bj) {
                        const u32x4 a = gp[m][bj], b = gr[m][bj];
                        f32x4& v0 = acc[ai][bj][mh * 2 + m][0]; f32x4& v1 = acc[ai][bj][mh * 2 + m][1];
                        if (mode == 0) {
                            v0[0] *= bf_lo(a.x) * __builtin_amdgcn_rcpf(bf_lo(b.x)); v0[1] *= bf_hi(a.x) * __builtin_amdgcn_rcpf(bf_hi(b.x));
                            v0[2] *= bf_lo(a.y) * __builtin_amdgcn_rcpf(bf_lo(b.y)); v0[3] *= bf_hi(a.y) * __builtin_amdgcn_rcpf(bf_hi(b.y));
                            v1[0] *= bf_lo(a.z) * __builtin_amdgcn_rcpf(bf_lo(b.z)); v1[1] *= bf_hi(a.z) * __builtin_amdgcn_rcpf(bf_hi(b.z));
                            v1[2] *= bf_lo(a.w) * __builtin_amdgcn_rcpf(bf_lo(b.w)); v1[3] *= bf_hi(a.w) * __builtin_amdgcn_rcpf(bf_hi(b.w));
                        } else {
                            v0[0] *= bf_lo(a.x); v0[1] *= bf_hi(a.x); v0[2] *= bf_lo(a.y); v0[3] *= bf_hi(a.y);
                            v1[0] *= bf_lo(a.z); v1[1] *= bf_hi(a.z); v1[2] *= bf_lo(a.w); v1[3] *= bf_hi(a.w);
                        }
                    }
            }
            if (mode == 0) return true;
#pragma unroll
            for (int ai = 0; ai < 2; ++ai)
#pragma unroll
                for (int bj = 0; bj < 2; ++bj) {
                    f32x4* mq = (f32x4*)m1 + launder((((wr * 4 + wc) * 4 + ai * 2 + bj) * 64 + fq * 16 + fr) * 8);
#pragma unroll
                    for (int m = 0; m < 4; ++m)
#pragma unroll
                        for (int n = 0; n < 2; ++n) store_wt(mq + (m * 2 + n), acc[ai][bj][m][n]);
                }
            asm volatile("s_waitcnt vmcnt(0)" ::: "memory");
            if (fr == 0 && fq == 0) __hip_atomic_fetch_add(flag, 1u, __ATOMIC_RELAXED, __HIP_MEMORY_SCOPE_AGENT);
            return false;
        }
        if (mode == 3) {
            unsigned sp = 0;
            while (__hip_atomic_load(flag, __ATOMIC_RELAXED, __HIP_MEMORY_SCOPE_AGENT) < 8u) { __builtin_amdgcn_s_sleep(2); if (++sp > (1u << 22)) break; }
            __builtin_amdgcn_fence(__ATOMIC_ACQUIRE, "agent");
            asm volatile("s_waitcnt vmcnt(0)" ::: "memory");
#pragma unroll
            for (int ai = 0; ai < 2; ++ai)
#pragma unroll
                for (int bj = 0; bj < 2; ++bj) {
                    u32x4 gr[4]; f32x4 mv[4][2];
                    const f32x4* mq3 = (const f32x4*)m1 + launder((((wr * 4 + wc) * 4 + ai * 2 + bj) * 64 + fq * 16 + fr) * 8);
#pragma unroll
                    for (int m = 0; m < 4; ++m) { gr[m] = *(const u32x4*)(zb + (size_t)(rbase + ai * 128 + m * 16) * ZW + ZC_GR + c0 + bj * 128);
#pragma unroll
                        for (int n = 0; n < 2; ++n) mv[m][n] = mq3[m * 2 + n]; }
#pragma unroll
                    for (int m = 0; m < 4; ++m) {
                        const int r = rbase + ai * 128 + m * 16;
                        const u32x4 b = gr[m];
                        f32x4 v0 = acc[ai][bj][m][0], v1 = acc[ai][bj][m][1];
                        v0[0] *= bf_lo(b.x); v0[1] *= bf_hi(b.x); v0[2] *= bf_lo(b.y); v0[3] *= bf_hi(b.y);
                        v1[0] *= bf_lo(b.z); v1[1] *= bf_hi(b.z); v1[2] *= bf_lo(b.w); v1[3] *= bf_hi(b.w);
                        v0 += mv[m][0]; v1 += mv[m][1];
                        u32x4 w; w.x = pk_bf16(v0[0], v0[1]); w.y = pk_bf16(v0[2], v0[3]); w.z = pk_bf16(v1[0], v1[1]); w.w = pk_bf16(v1[2], v1[3]);
                        *(u32x4*)(merged + (size_t)r * D + c0 + bj * 128) = w;
                    }
                }
            return false;
        }
        u32x4 gr[2][4][2];
#pragma unroll
        for (int ai = 0; ai < 2; ++ai)
#pragma unroll
            for (int m = 0; m < 4; ++m)
#pragma unroll
                for (int bj = 0; bj < 2; ++bj) gr[ai][m][bj] = *(const u32x4*)(zb + (size_t)(rbase + ai * 128 + m * 16) * ZW + ZC_GR + c0 + bj * 128);
#pragma unroll
        for (int ai = 0; ai < 2; ++ai)
#pragma unroll
            for (int m = 0; m < 4; ++m) {
                const int r = rbase + ai * 128 + m * 16;
#pragma unroll
                for (int bj = 0; bj < 2; ++bj) {
                    const u32x4 b = gr[ai][m][bj];
                    const f32x4 v0 = acc[ai][bj][m][0], v1 = acc[ai][bj][m][1];
                    u32x4 w; w.x = pk_bf16(v0[0] * bf_lo(b.x), v0[1] * bf_hi(b.x)); w.y = pk_bf16(v0[2] * bf_lo(b.y), v0[3] * bf_hi(b.y));
                    w.z = pk_bf16(v1[0] * bf_lo(b.z), v1[1] * bf_hi(b.z)); w.w = pk_bf16(v1[2] * bf_lo(b.w), v1[3] * bf_hi(b.w));
                    *(u32x4*)(merged + (size_t)r * D + c0 + bj * 128) = w;
                }
            }
        return false;
    }
};

struct EpiOut {
    float* xf; bf16_t* xb; float* rsq_next;
    __device__ __forceinline__ bool operator()(f32x4 (&acc)[2][2][4][2], const Unit& un, int wr, int wc, int fr, int fq) const {
        const int c0 = un.pn * 256 + wc * 32 + 8 * fq;
        const int rbase = un.pm * 256 + wr * 64 + fr;
#pragma unroll
        for (int ai = 0; ai < 2; ++ai) {
            f32x4 xv[4][2][2];
#pragma unroll
            for (int m = 0; m < 4; ++m)
#pragma unroll
                for (int bj = 0; bj < 2; ++bj) { const float* xp = xf + (size_t)(rbase + ai * 128 + m * 16) * D + c0 + bj * 128;
                    xv[m][bj][0] = *(const f32x4*)xp; xv[m][bj][1] = *(const f32x4*)(xp + 4); }
#pragma unroll
            for (int m = 0; m < 4; ++m) {
                const int r = rbase + ai * 128 + m * 16;
                float ssq = 0.f;
#pragma unroll
                for (int bj = 0; bj < 2; ++bj) {
                    float* xp = xf + (size_t)r * D + c0 + bj * 128;
                    const f32x4 v0 = xv[m][bj][0] + acc[ai][bj][m][0], v1 = xv[m][bj][1] + acc[ai][bj][m][1];
                    *(f32x4*)xp = v0; *(f32x4*)(xp + 4) = v1;
                    u32x4 w; w.x = pk_bf16(v0[0], v0[1]); w.y = pk_bf16(v0[2], v0[3]); w.z = pk_bf16(v1[0], v1[1]); w.w = pk_bf16(v1[2], v1[3]);
                    *(u32x4*)(xb + (size_t)r * D + c0 + bj * 128) = w;
#pragma unroll
                    for (int j = 0; j < 4; ++j) ssq += v0[j] * v0[j] + v1[j] * v1[j];
                }
                if (rsq_next) atomicAdd(rsq_next + r, ssq);
            }
        }
        return false;
    }
};

__device__ __forceinline__ int swz(int row) { return ((row & 3) << 2) | ((row >> 2) & 3); }
__device__ __forceinline__ int img_off(int row, int col) {
    const int sub = col >> 7, cc = col & 127;
    return sub * 32768 + 256 * row + 16 * ((cc >> 3) ^ swz(row)) + (cc & 7) * 2;
}
__device__ __forceinline__ bf16x8 frag_direct(LAS unsigned char* base, int r0, int k0, int lane) {
    return *(const LAS bf16x8*)(base + img_off(r0 + (lane & 15), k0 + 8 * (lane >> 4)));
}
__device__ __forceinline__ bf16x8 frag_tr(LAS unsigned char* base, int k0, int c0, int lane) {
    const int g = lane >> 4, q = (lane >> 2) & 3, p = lane & 3;
    const int row = k0 + 8 * g + q, col = c0 + 4 * p;
    const s16x4 lo = __builtin_amdgcn_ds_read_tr16_b64_v4i16((LAS s16x4*)(base + img_off(row, col)));
    const s16x4 hi = __builtin_amdgcn_ds_read_tr16_b64_v4i16((LAS s16x4*)(base + img_off(row + 4, col)));
    bf16x8 r; r[0] = lo[0]; r[1] = lo[1]; r[2] = lo[2]; r[3] = lo[3]; r[4] = hi[0]; r[5] = hi[1]; r[6] = hi[2]; r[7] = hi[3];
    return r;
}
template <bool SCALE>
__device__ __forceinline__ void load_tile(LAS unsigned char* dst, const bf16_t* src, size_t ld, int nvalid, float lg, int tid) {
#pragma unroll
    for (int i = 0; i < 8; ++i) {
        const int idx = i * 512 + tid, row = idx >> 5, ch = idx & 31;
        u32x4 v = (u32x4){0u, 0u, 0u, 0u};
        if (row < nvalid) {
            v = *(const u32x4*)(src + (size_t)row * ld + ch * 8);
            if (SCALE) { const float f = exp2f(lg * (float)(nvalid - 1 - row));
                v.x = pk_bf16(bf_lo(v.x) * f, bf_hi(v.x) * f); v.y = pk_bf16(bf_lo(v.y) * f, bf_hi(v.y) * f);
                v.z = pk_bf16(bf_lo(v.z) * f, bf_hi(v.z) * f); v.w = pk_bf16(bf_lo(v.w) * f, bf_hi(v.w) * f); }
        }
        *(LAS u32x4*)(dst + img_off(row, ch * 8)) = v;
    }
}

__device__ __forceinline__ void tr_tile(LAS float* tile, const float* src, int N, bf16_t* dst, int Kd, int k0, int n0, const float* scale, const float* nscale, int tid) {
    constexpr int P = 257;
    f32x4 v[8];
#pragma unroll
    for (int i = 0; i < 8; ++i) { const int idx4 = i * 512 + tid, r = idx4 >> 6, c4 = (idx4 & 63) * 4;
        v[i] = __builtin_nontemporal_load((const f32x4*)(src + (size_t)(k0 + r) * N + n0 + c4)); }
#pragma unroll
    for (int i = 0; i < 8; ++i) { const int idx4 = i * 512 + tid, r = idx4 >> 6, c4 = (idx4 & 63) * 4;
        f32x4 w = v[i]; if (scale) w *= scale[k0 + r]; if (nscale) w *= *(const f32x4*)(nscale + n0 + c4);
        tile[r * P + c4] = w[0]; tile[r * P + c4 + 1] = w[1]; tile[r * P + c4 + 2] = w[2]; tile[r * P + c4 + 3] = w[3]; }
    __syncthreads();
#pragma unroll
    for (int i = 0; i < 8; ++i) { const int idx = i * 512 + tid, n = idx >> 4, k4 = (idx & 15) * 4;
        u32x2 w; w.x = pk_bf16(tile[(k4) * P + n], tile[(k4 + 1) * P + n]); w.y = pk_bf16(tile[(k4 + 2) * P + n], tile[(k4 + 3) * P + n]);
        *(u32x2*)(dst + (size_t)(n0 + n) * Kd + k0 + k4) = w; }
    __syncthreads();
}

__device__ __forceinline__ void conv_item(const Params& p, int l, int t, LAS unsigned char* lds, int tid) {
    LAS float* tile = (LAS float*)lds;
    if (t < 2048) { const int kt = t >> 6, nt_ = t & 63;
        tr_tile(tile, p.w_in + (size_t)l * D * NIN, NIN, (bf16_t*)(pws(p) + OFF_WIN + l * SZ_WIN), D, kt * 64, nt_ * 256, p.norm_gain + l * D, nullptr, tid);
    } else if (t < 2112) { const int g = (t - 2048) >> 4, tt = (t - 2048) & 15, kt = tt >> 1, nt_ = tt & 1;
        tr_tile(tile, p.pool_w + ((size_t)l * 4 + g) * 512 * 512, 512, (bf16_t*)(pws(p) + OFF_WPOOL + l * SZ_WPOOL) + (size_t)g * 512 * 512, 512, kt * 64, nt_ * 256, nullptr, p.pool_scale + (size_t)l * D + g * 512, tid);
    } else { const int j = (t - 2112) >> 8, tt = (t - 2112) & 255, kt = tt >> 3, nt_ = tt & 7;
        const float* src = (j == 0 ? p.proj_pool : j == 1 ? p.proj_ret : p.w_out) + (size_t)l * D * D;
        bf16_t* dst = j == 2 ? (bf16_t*)(pws(p) + OFF_WOUT + l * SZ_WOUT) : (bf16_t*)(pws(p) + OFF_WPR + l * SZ_WPR) + (size_t)j * D * D;
        tr_tile(tile, src, D, dst, D, kt * 64, nt_ * 256, nullptr, nullptr, tid);
    }
}

__device__ void phase0(const Params& p, LAS unsigned char* lds, const int tid_in, const int bid) {
    const int tid = launder(tid_in);
    const int wid = tid >> 6, lane = tid & 63;
    constexpr int NT_L = 2880, NROWI = MPAD / 8;
    if (bid == 0 && tid < 128) {
        const float invf = powf(10000.0f, -(float)tid / 128.0f);
        const double c = (double)invf * 0.15915494309189535;
        const float hi = (float)c, lo = (float)(c - (double)hi);
        float* cf = (float*)(pws(p) + OFF_CS) + tid * 2; cf[0] = hi; cf[1] = lo;
    }
    for (int it = bid; it < NT_L + NROWI; it += gridDim.x) {
        if (it < NT_L) {
            conv_item(p, 0, it, lds, tid);
        } else {
            const int row = (it - NT_L) * 8 + wid;
            float* xf = (float*)(pws(p) + OFF_XF) + (size_t)row * D; bf16_t* xb = (bf16_t*)(pws(p) + OFF_XB) + (size_t)row * D; float* rsq = (float*)(pws(p) + OFF_RSQ);
            const float* src = nullptr;
            if (row < MS) src = p.x_sample + (size_t)row * D;
            else if (row < MR) { const int pr = row - MS, b = pr / LP, pp = pr % LP; src = pp < 16 ? p.meta + (size_t)pp * D : p.x_prompt + ((size_t)b * 2048 + pp - 16) * D; }
            f32x4 v[8];
#pragma unroll
            for (int i = 0; i < 8; ++i) { v[i] = (f32x4){0.f, 0.f, 0.f, 0.f}; if (src) v[i] = *(const f32x4*)(src + i * 256 + lane * 4); }
            float ss = 0.f;
#pragma unroll
            for (int i = 0; i < 8; ++i) { const int c = i * 256 + lane * 4;
                *(f32x4*)(xf + c) = v[i]; u32x2 w; w.x = pk_bf16(v[i][0], v[i][1]); w.y = pk_bf16(v[i][2], v[i][3]); *(u32x2*)(xb + c) = w;
                ss += v[i][0] * v[i][0] + v[i][1] * v[i][1] + v[i][2] * v[i][2] + v[i][3] * v[i][3]; }
            ss = wave_sum(ss);
            if (lane == 0) { rsq[row] = ss; rsq[MPAD + row] = 0.f; }
        }
    }
}

__device__ void sample_ret_unit(const Params& p, int l, int unit, LAS unsigned char* lds, const int tid_in) {
    const int tid = launder(tid_in);
    const int wid = tid >> 6, lane = tid & 63;
    const int b = unit >> 3, h = unit & 7, r0 = b * 8;
    const float lg = lg2gamma(h);
    LAS float* sq = (LAS float*)lds; LAS float* sk = sq + 2048; LAS float* sv = sk + 2048; LAS float* sqT = sv + 2048; LAS float* skdT = sqT + 2048; LAS float* sc = skdT + 2048; LAS float* red = (LAS float*)(lds + 49152);
    const bf16_t* zb = (const bf16_t*)(pws(p) + OFF_ZB);
    { const int i = tid >> 6, d = (tid & 63) * 4; const bf16_t* zr = zb + (size_t)(r0 + i) * ZW + h * 256 + d;
        const u32x2 a = *(const u32x2*)(zr + ZC_Q), kk = *(const u32x2*)(zr + ZC_K), vv = *(const u32x2*)(zr + ZC_V);
        const float qf[4] = {bf_lo(a.x), bf_hi(a.x), bf_lo(a.y), bf_hi(a.y)}, kf[4] = {bf_lo(kk.x), bf_hi(kk.x), bf_lo(kk.y), bf_hi(kk.y)};
        const float dk = exp2f(lg * (float)(7 - i));
        *(LAS f32x4*)(sq + i * 256 + d) = (f32x4){qf[0], qf[1], qf[2], qf[3]};
        *(LAS f32x4*)(sk + i * 256 + d) = (f32x4){kf[0], kf[1], kf[2], kf[3]};
        *(LAS f32x4*)(sv + i * 256 + d) = (f32x4){bf_lo(vv.x), bf_hi(vv.x), bf_lo(vv.y), bf_hi(vv.y)};
#pragma unroll
        for (int j = 0; j < 4; ++j) { sqT[(d + j) * 8 + i] = qf[j]; skdT[(d + j) * 8 + i] = kf[j] * dk; } }
    __syncthreads();
    { const int i = wid; const f32x4 qv = *(const LAS f32x4*)(sq + i * 256 + lane * 4);
        for (int j = 0; j < 8; ++j) { const f32x4 kv = *(const LAS f32x4*)(sk + j * 256 + lane * 4);
            float s = wave_sum(qv[0] * kv[0] + qv[1] * kv[1] + qv[2] * kv[2] + qv[3] * kv[3]);
            if (lane == 0) sc[i * 8 + j] = j <= i ? s * exp2f(lg * (float)(i - j)) : 0.f; } }
    const int e4 = lane * 4;
    f32x4 vv[8], oacc[8];
#pragma unroll
    for (int j = 0; j < 8; ++j) { vv[j] = *(const LAS f32x4*)(sv + j * 256 + e4); oacc[j] = (f32x4){0.f, 0.f, 0.f, 0.f}; }
    const float g8 = exp2f(lg * 8.0f);
    const size_t sbase = (((size_t)l * 128 + b) * 8 + h) * 65536;
    const float* Sin = p.state_ret + sbase; float* Sout = pout(p) + O_RS + sbase;
    f32x4 S4[8], N4[8];
#pragma unroll
    for (int u = 0; u < 8; ++u) S4[u] = __builtin_nontemporal_load((const f32x4*)(Sin + (size_t)(wid * 32 + u) * 256 + e4));
#pragma unroll
    for (int dd = 0; dd < 32; dd += 8) {
        const int d0 = launder(wid * 32 + dd);
        const int dn = dd + 8 < 32 ? d0 + 8 : d0;
#pragma unroll
        for (int u = 0; u < 8; ++u) N4[u] = __builtin_nontemporal_load((const f32x4*)(Sin + (size_t)(dn + u) * 256 + e4));
        asm volatile("" ::: "memory");
#pragma unroll
        for (int u = 0; u < 8; ++u) {
            const f32x4 q0 = *(const LAS f32x4*)(sqT + (d0 + u) * 8), q1 = *(const LAS f32x4*)(sqT + (d0 + u) * 8 + 4);
            const f32x4 k0 = *(const LAS f32x4*)(skdT + (d0 + u) * 8), k1 = *(const LAS f32x4*)(skdT + (d0 + u) * 8 + 4);
            f32x4 sn = S4[u] * g8;
            sn += vv[0] * k0[0]; sn += vv[1] * k0[1]; sn += vv[2] * k0[2]; sn += vv[3] * k0[3];
            sn += vv[4] * k1[0]; sn += vv[5] * k1[1]; sn += vv[6] * k1[2]; sn += vv[7] * k1[3];
            __builtin_nontemporal_store(sn, (f32x4*)(Sout + (size_t)(d0 + u) * 256 + e4));
            oacc[0] += S4[u] * q0[0]; oacc[1] += S4[u] * q0[1]; oacc[2] += S4[u] * q0[2]; oacc[3] += S4[u] * q0[3];
            oacc[4] += S4[u] * q1[0]; oacc[5] += S4[u] * q1[1]; oacc[6] += S4[u] * q1[2]; oacc[7] += S4[u] * q1[3];
        }
        asm volatile("" ::: "memory");
#pragma unroll
        for (int u = 0; u < 8; ++u) S4[u] = N4[u];
    }
#pragma unroll
    for (int i = 0; i < 8; ++i) *(LAS f32x4*)(red + (wid * 8 + i) * 256 + e4) = oacc[i];
    __syncthreads();
    { const int i = wid;
        f32x4 o = (f32x4){0.f, 0.f, 0.f, 0.f};
#pragma unroll
        for (int w = 0; w < 8; ++w) o += *(const LAS f32x4*)(red + (w * 8 + i) * 256 + e4);
        o *= exp2f(lg * (float)(i + 1));
        for (int j = 0; j <= i; ++j) o += *(const LAS f32x4*)(sv + j * 256 + e4) * sc[i * 8 + j];
        const float mu = wave_sum(o[0] + o[1] + o[2] + o[3]) * (1.0f / 256.0f);
        o -= mu;
        const float var = wave_sum(o[0] * o[0] + o[1] * o[1] + o[2] * o[2] + o[3] * o[3]) * (1.0f / 256.0f);
        const float rs = rsqrtf(var + EPS);
        const f32x4 gn = *(const f32x4*)(p.ret_gn + (size_t)l * D + h * 256 + e4);
        const u32x2 rg = *(const u32x2*)(zb + (size_t)(r0 + i) * ZW + ZC_RG + h * 256 + e4);
        u32x2 w; w.x = pk_bf16(o[0] * rs * gn[0] * bf_lo(rg.x), o[1] * rs * gn[1] * bf_hi(rg.x)); w.y = pk_bf16(o[2] * rs * gn[2] * bf_lo(rg.y), o[3] * rs * gn[3] * bf_hi(rg.y));
        *(u32x2*)((bf16_t*)(pws(p) + OFF_AIN) + ((size_t)MPAD + r0 + i) * D + h * 256 + e4) = w; }
    __syncthreads();
}

__device__ __forceinline__ void chunk_geom(int unit, int& b, int& h, int& c, int& n, int& R0, int& slot) {
    int bh; if (unit < 32) { bh = unit; c = 0; } else { bh = (unit - 32) >> 4; c = 1 + ((unit - 32) & 15); }
    b = bh >> 3; h = bh & 7;
    n = c ? 128 : 16; R0 = MS + b * LP + (c ? 16 + 128 * (c - 1) : 0); slot = bh * 17 + c;
}

__device__ void kv_unit(const Params& p, int unit, LAS unsigned char* lds, const int tid_in) {
    const int tid = launder(tid_in); const int wid = __builtin_amdgcn_readfirstlane(tid >> 6);
    int b, h, c, n, R0, slot; chunk_geom(unit, b, h, c, n, R0, slot);
    const float lg = lg2gamma(h);
    const bf16_t* zb = (const bf16_t*)(pws(p) + OFF_ZB) + (size_t)R0 * ZW + h * 256;
    LAS unsigned char* regA = lds; LAS unsigned char* regB = lds + 65536;
    load_tile<true>(regA, zb + ZC_K, ZW, n, lg, tid);
    load_tile<false>(regB, zb + ZC_V, ZW, n, 0.f, tid);
    __syncthreads();
    const int db = (wid >> 1) * 64, ebase = (wid & 1) * 128;
    float* kv = (float*)(pws(p) + OFF_KV) + (size_t)slot * 65536;
    const int nks = n >> 5 ? n >> 5 : 1;
#pragma unroll 1
    for (int pass = 0; pass < 4; ++pass) {
        const int eb = ebase + pass * 32;
        const int lane = launder(tid) & 63;
        f32x4 acc[4][2];
#pragma unroll
        for (int i = 0; i < 4; ++i)
#pragma unroll
            for (int j = 0; j < 2; ++j) acc[i][j] = (f32x4){0.f, 0.f, 0.f, 0.f};
#pragma unroll 1
        for (int ks = 0; ks < nks; ++ks) {
            bf16x8 a[4], bb[2];
#pragma unroll
            for (int i = 0; i < 4; ++i) a[i] = frag_tr(regA, ks * 32, db + i * 16, lane);
#pragma unroll
            for (int j = 0; j < 2; ++j) bb[j] = frag_tr(regB, ks * 32, eb + j * 16, lane);
#pragma unroll
            for (int i = 0; i < 4; ++i)
#pragma unroll
                for (int j = 0; j < 2; ++j) acc[i][j] = __builtin_amdgcn_mfma_f32_16x16x32_bf16(a[i], bb[j], acc[i][j], 0, 0, 0);
        }
        float* kp = kv + (size_t)(db + 4 * (lane >> 4)) * 256 + eb + (lane & 15);
#pragma unroll
        for (int i = 0; i < 4; ++i)
#pragma unroll
            for (int jj = 0; jj < 4; ++jj)
#pragma unroll
                for (int j = 0; j < 2; ++j) kp[(i * 16 + jj) * 256 + j * 16] = acc[i][j][jj];
    }
    __syncthreads();
}

__device__ void pool_item(const Params& p, int l, int item, const int tid_in) {
    const int tid = launder(tid_in);
    const int col = tid * 4, g = tid >> 7, w = 2 << g;
    const float* u = (const float*)(pws(p) + OFF_U);
    bf16_t* pooled = (bf16_t*)(pws(p) + OFF_POOLED);
    f32x4 p_self = (f32x4){0.f, 0.f, 0.f, 0.f}, p_res = p_self, p_hist = p_self;
#pragma unroll 1
    for (int rr = 0; rr <= 16; ++rr) {
        const int row = item * 16 + rr;
        f32x4 self = (f32x4){0.f, 0.f, 0.f, 0.f}, sum = self, hcopy = self; float cnt = 1.f;
        if (rr < 16) {
            self = *(const f32x4*)(u + (size_t)row * D + col); sum = self;
            if (row < MS) {
                const int b = row >> 3, t = row & 7;
                const float* hist = p.state_pool + ((size_t)l * 128 + b) * 15 * D + col;
                for (int i = 1; i < w; ++i) { const int tt = t - i;
                    sum += tt >= 0 ? *(const f32x4*)(u + (size_t)(row - i) * D + col) : *(const f32x4*)(hist + (size_t)(15 + tt) * D); }
                cnt = (float)w;
                if (t < 7) hcopy = *(const f32x4*)(hist + (size_t)(8 + t) * D);
            } else {
                const int pp = (row - MS) % LP;
                for (int i = 1; i < w; ++i) if (pp - i >= 0) sum += *(const f32x4*)(u + (size_t)(row - i) * D + col);
                cnt = (float)(w < pp + 1 ? w : pp + 1);
            }
        }
        asm volatile("" ::: "memory");
        if (rr > 0) {
            const int prow = row - 1;
            u32x2 o; o.x = pk_bf16(p_res[0], p_res[1]); o.y = pk_bf16(p_res[2], p_res[3]);
            *(u32x2*)(pooled + (size_t)prow * D + col) = o;
            if (prow < MS) {
                const int b = prow >> 3, t = prow & 7;
                float* np = pout(p) + O_PS + ((size_t)l * 128 + b) * 15 * D + col;
                *(f32x4*)(np + (size_t)(7 + t) * D) = p_self;
                if (t < 7) *(f32x4*)(np + (size_t)t * D) = p_hist;
            } else {
                const int pr = prow - MS, b = pr / LP, pp = pr % LP;
                if (pp >= 2049) *(f32x4*)(pout(p) + O_PP + (((size_t)l * 4 + b) * 15 + (pp - 2049)) * D + col) = p_self;
            }
        }
        asm volatile("" ::: "memory");
        p_res = sum * (1.0f / cnt) - self; p_self = self; p_hist = hcopy;
    }
}

__device__ void scan_item2(const Params& p, int l, int itemA, int itemB, const int tid_in) {
    const int tid = launder(tid_in);
    const int bhA = itemA >> 5, eA = ((itemA & 31) * 512 + tid) * 4, bhB = itemB >> 5, eB = ((itemB & 31) * 512 + tid) * 4;
    const float dA = exp2f(lg2gamma(bhA & 7) * 128.0f), dB = exp2f(lg2gamma(bhB & 7) * 128.0f);
    const float* kvA = (const float*)(pws(p) + OFF_KV) + (size_t)bhA * 17 * 65536 + eA;
    const float* kvB = (const float*)(pws(p) + OFF_KV) + (size_t)bhB * 17 * 65536 + eB;
    bf16_t* sbA = (bf16_t*)(pws(p) + OFF_SB) + (size_t)bhA * 17 * 65536 + eA;
    bf16_t* sbB = (bf16_t*)(pws(p) + OFF_SB) + (size_t)bhB * 17 * 65536 + eB;
    f32x4 ka[17], kb[17];
#pragma unroll
    for (int c = 0; c < 17; ++c) { ka[c] = __builtin_nontemporal_load((const f32x4*)(kvA + (size_t)c * 65536)); kb[c] = __builtin_nontemporal_load((const f32x4*)(kvB + (size_t)c * 65536)); }
    asm volatile("" ::: "memory");
    f32x4 SA = ka[0], SB = kb[0];
#pragma unroll
    for (int c = 1; c < 17; ++c) {
        u32x2 w; w.x = pk_bf16(SA[0], SA[1]); w.y = pk_bf16(SA[2], SA[3]);
        *(u32x2*)(sbA + (size_t)c * 65536) = w;
        w.x = pk_bf16(SB[0], SB[1]); w.y = pk_bf16(SB[2], SB[3]);
        *(u32x2*)(sbB + (size_t)c * 65536) = w;
        SA = SA * dA + ka[c]; SB = SB * dB + kb[c];
    }
    *(f32x4*)(pout(p) + O_RP + ((size_t)l * 32 + bhA) * 65536 + eA) = SA;
    *(f32x4*)(pout(p) + O_RP + ((size_t)l * 32 + bhB) * 65536 + eB) = SB;
}

__device__ void ret_out_unit(const Params& p, int l, int unit, LAS unsigned char* lds, const int tid_in) {
    const int tid = launder(tid_in); const int wid = __builtin_amdgcn_readfirstlane(tid >> 6);
    int b, h, c, n, R0, slot; chunk_geom(unit, b, h, c, n, R0, slot);
    const float lg = lg2gamma(h);
    const bf16_t* zb = (const bf16_t*)(pws(p) + OFF_ZB) + (size_t)R0 * ZW + h * 256;
    LAS unsigned char* regA = lds; LAS unsigned char* regB = lds + 65536;
    load_tile<false>(regA, zb + ZC_Q, ZW, n, 0.f, tid);
    load_tile<false>(regB, zb + ZC_K, ZW, n, 0.f, tid);
    __syncthreads();
    const int jb = (wid & 3) * 32, ib = (wid >> 2) * 64;
    u32x2 pk[2][4];
    {
        const int lane = launder(tid) & 63, g = lane >> 4, lc = lane & 15;
        f32x4 sc[2][4];
#pragma unroll
        for (int i = 0; i < 2; ++i)
#pragma unroll
            for (int j = 0; j < 4; ++j) sc[i][j] = (f32x4){0.f, 0.f, 0.f, 0.f};
#pragma unroll 1
        for (int ks = 0; ks < 8; ++ks) {
            bf16x8 a[2], bq[4];
#pragma unroll
            for (int i = 0; i < 2; ++i) a[i] = frag_direct(regB, jb + i * 16, ks * 32, lane);
#pragma unroll
            for (int j = 0; j < 4; ++j) bq[j] = frag_direct(regA, ib + j * 16, ks * 32, lane);
#pragma unroll
            for (int i = 0; i < 2; ++i)
#pragma unroll
                for (int j = 0; j < 4; ++j) sc[i][j] = __builtin_amdgcn_mfma_f32_16x16x32_bf16(a[i], bq[j], sc[i][j], 0, 0, 0);
        }
#pragma unroll
        for (int i = 0; i < 2; ++i)
#pragma unroll
            for (int j = 0; j < 4; ++j) {
                const int ii = ib + j * 16 + lc; float v[4];
#pragma unroll
                for (int jj = 0; jj < 4; ++jj) { const int jx = jb + i * 16 + 4 * g + jj; v[jj] = jx <= ii ? sc[i][j][jj] * exp2f(lg * (float)(ii - jx)) : 0.f; }
                pk[i][j].x = pk_bf16(v[0], v[1]); pk[i][j].y = pk_bf16(v[2], v[3]);
            }
    }
    const int ib2 = (wid >> 1) * 32, eb = (wid & 1) * 128;
    f32x4 acc[2][8];
#pragma unroll
    for (int i = 0; i < 2; ++i)
#pragma unroll
        for (int j = 0; j < 8; ++j) acc[i][j] = (f32x4){0.f, 0.f, 0.f, 0.f};
    if (c > 0) {
        const int lane = launder(tid) & 63, g = lane >> 4;
        const bf16_t* sb = (const bf16_t*)(pws(p) + OFF_SB) + (size_t)slot * 65536;
#pragma unroll 1
        for (int half = 0; half < 2; ++half) {
            __syncthreads();
            load_tile<false>(regB, sb + (size_t)half * 128 * 256, 256, 128, 0.f, tid);
            __syncthreads();
#pragma unroll 1
            for (int ks = 0; ks < 4; ++ks) {
                bf16x8 a[2];
#pragma unroll
                for (int i = 0; i < 2; ++i) a[i] = frag_direct(regA, ib2 + i * 16, half * 128 + ks * 32, lane);
#pragma unroll
                for (int j = 0; j < 8; ++j) { const bf16x8 bs = frag_tr(regB, ks * 32, eb + j * 16, lane);
#pragma unroll
                    for (int i = 0; i < 2; ++i) acc[i][j] = __builtin_amdgcn_mfma_f32_16x16x32_bf16(a[i], bs, acc[i][j], 0, 0, 0); }
            }
        }
#pragma unroll
        for (int i = 0; i < 2; ++i)
#pragma unroll
            for (int jj = 0; jj < 4; ++jj) { const float f = exp2f(lg * (float)(ib2 + i * 16 + 4 * g + jj + 1));
#pragma unroll
                for (int j = 0; j < 8; ++j) acc[i][j][jj] *= f; }
    }
    __syncthreads();
    { const int lane = launder(tid) & 63, g = lane >> 4, lc = lane & 15;
#pragma unroll
    for (int i = 0; i < 2; ++i)
#pragma unroll
        for (int j = 0; j < 4; ++j) *(LAS u32x2*)(regA + img_off(ib + j * 16 + lc, jb + i * 16 + 4 * g)) = pk[i][j]; }
    load_tile<false>(regB, zb + ZC_V, ZW, n, 0.f, tid);
    __syncthreads();
    const int ksmax = (ib2 + 31) >> 5;
    { const int lane = launder(tid) & 63;
#pragma unroll 1
    for (int ks = 0; ks <= ksmax; ++ks) {
        bf16x8 a[2];
#pragma unroll
        for (int i = 0; i < 2; ++i) a[i] = frag_direct(regA, ib2 + i * 16, ks * 32, lane);
#pragma unroll
        for (int j = 0; j < 8; ++j) { const bf16x8 bs = frag_tr(regB, ks * 32, eb + j * 16, lane);
#pragma unroll
            for (int i = 0; i < 2; ++i) acc[i][j] = __builtin_amdgcn_mfma_f32_16x16x32_bf16(a[i], bs, acc[i][j], 0, 0, 0); }
    } }
    __syncthreads();
    LAS float* oL = (LAS float*)lds;
    { const int lane = launder(tid) & 63, g = lane >> 4, lc = lane & 15;
#pragma unroll
    for (int i = 0; i < 2; ++i)
#pragma unroll
        for (int j = 0; j < 8; ++j)
#pragma unroll
            for (int jj = 0; jj < 4; ++jj) oL[(ib2 + i * 16 + 4 * g + jj) * 260 + eb + j * 16 + lc] = acc[i][j][jj]; }
    __syncthreads();
    const int lane = launder(tid) & 63;
    const f32x4 gn = *(const f32x4*)(p.ret_gn + (size_t)l * D + h * 256 + lane * 4);
    u32x2 rgv[16];
#pragma unroll
    for (int rr = 0; rr < 16; ++rr) { const int i = wid * 16 + rr; rgv[rr] = (u32x2){0u, 0u};
        if (i < n) rgv[rr] = *(const u32x2*)(zb + (size_t)i * ZW + ZC_RG + lane * 4); }
    asm volatile("" ::: "memory");
#pragma unroll
    for (int rr = 0; rr < 16; ++rr) {
        const int i = wid * 16 + rr;
        if (i < n) {
            f32x4 o = *(const LAS f32x4*)(oL + i * 260 + lane * 4);
            const float mu = wave_sum(o[0] + o[1] + o[2] + o[3]) * (1.0f / 256.0f);
            o -= mu;
            const float var = wave_sum(o[0] * o[0] + o[1] * o[1] + o[2] * o[2] + o[3] * o[3]) * (1.0f / 256.0f);
            const float rs = rsqrtf(var + EPS);
            const u32x2 rg = rgv[rr];
            u32x2 w; w.x = pk_bf16(o[0] * rs * gn[0] * bf_lo(rg.x), o[1] * rs * gn[1] * bf_hi(rg.x)); w.y = pk_bf16(o[2] * rs * gn[2] * bf_lo(rg.y), o[3] * rs * gn[3] * bf_hi(rg.y));
            *(u32x2*)((bf16_t*)(pws(p) + OFF_AIN) + ((size_t)MPAD + R0 + i) * D + h * 256 + lane * 4) = w;
        }
    }
    __syncthreads();
}

__device__ __forceinline__ float* final_dst(const Params& p, int row) {
    if (row < MS) return pout(p) + O_YS + (size_t)row * D;
    const int pr = row - MS, b = pr / LP, pp = pr % LP;
    return pp < 16 ? nullptr : pout(p) + O_YP + ((size_t)b * 2048 + pp - 16) * D;
}
__device__ void final_item(const Params& p, int item, const int tid_in) {
    const int tid = launder(tid_in);
    const int wid = tid >> 6, lane = tid & 63, r0 = item * 16 + wid, r1 = r0 + 8;
    float* d0 = final_dst(p, r0); float* d1 = final_dst(p, r1);
    const float* x0 = (const float*)(pws(p) + OFF_XF) + (size_t)r0 * D; const float* x1 = x0 + (size_t)8 * D;
    f32x4 v0[8], v1[8]; float s0 = 0.f, s1 = 0.f;
#pragma unroll
    for (int i = 0; i < 8; ++i) { v0[i] = *(const f32x4*)(x0 + i * 256 + lane * 4); v1[i] = *(const f32x4*)(x1 + i * 256 + lane * 4); }
#pragma unroll
    for (int i = 0; i < 8; ++i) { s0 += v0[i][0] * v0[i][0] + v0[i][1] * v0[i][1] + v0[i][2] * v0[i][2] + v0[i][3] * v0[i][3];
        s1 += v1[i][0] * v1[i][0] + v1[i][1] * v1[i][1] + v1[i][2] * v1[i][2] + v1[i][3] * v1[i][3]; }
    const float rs0 = rsqrtf(wave_sum(s0) * (1.0f / 2048.0f) + EPS), rs1 = rsqrtf(wave_sum(s1) * (1.0f / 2048.0f) + EPS);
#pragma unroll
    for (int i = 0; i < 8; ++i) { const f32x4 gg = *(const f32x4*)(p.final_norm + i * 256 + lane * 4);
        if (d0) *(f32x4*)(d0 + i * 256 + lane * 4) = v0[i] * rs0 * gg;
        if (d1) *(f32x4*)(d1 + i * 256 + lane * 4) = v1[i] * rs1 * gg; }
}

#ifndef PH_MASK
#define PH_MASK 0xff
#endif
__device__ __forceinline__ void run_phase(const Params& p, int ph, LAS unsigned char* lds, const int tid, const int bid) {
    const int G = gridDim.x;
    if (ph == 0) { if (PH_MASK & 1) phase0(p, lds, tid, bid); return; }
    if (ph == 13) { if (PH_MASK & 128) for (int it = bid; it < MR / 16; it += G) final_item(p, it, tid); return; }
    const int l = (ph - 1) / 6, sub = (ph - 1) % 6;
    if (sub == 0) { if (PH_MASK & 2) {
        SchedPlain S; S.init(MPAD, NIN, G, bid); S.A = pws(p) + OFF_XB; S.Bt = pws(p) + OFF_WIN + l * SZ_WIN; S.tstepA = (size_t)256 * D * 2; S.tstepB = (size_t)256 * D * 2;
        EpiWin E; E.u = (float*)(pws(p) + OFF_U); E.zb = (bf16_t*)(pws(p) + OFF_ZB); E.rsq = (const float*)(pws(p) + OFF_RSQ) + (size_t)l * MPAD; E.cf = (const float*)(pws(p) + OFF_CS);
        gemm_phase(lds, S, E, D, D, D, tid); }
    } else if (sub == 1) { if (PH_MASK & 4)
        for (int it = bid; it < 1024 + 544 + 580; it += G) {
            if (it < 1024) sample_ret_unit(p, l, it, lds, tid);
            else if (it < 1568) kv_unit(p, it - 1024, lds, tid);
            else pool_item(p, l, it - 1568, tid);
        }
    } else if (sub == 2) { if (PH_MASK & 8) {
        for (int it = bid; it + G < 1024; it += 2 * G) scan_item2(p, l, it, it + G, tid); }
    } else if (sub == 3) { if (PH_MASK & 16) {
        SchedPool S; S.init(MPAD, D, G, (bid + 128) % G); S.A = pws(p) + OFF_POOLED; S.Bt = pws(p) + OFF_WPOOL + l * SZ_WPOOL;
        EpiPool E; E.ain = (bf16_t*)(pws(p) + OFF_AIN); E.zb = (const bf16_t*)(pws(p) + OFF_ZB);
        gemm_phase(lds, S, E, 512, D, 512, tid);
        for (int it = bid; it < 544; it += G) ret_out_unit(p, l, it, lds, launder(tid)); }
    } else if (sub == 4) { if (PH_MASK & 32) {
        SchedDual S; S.init(MPAD, D, G, bid); S.A = pws(p) + OFF_AIN; S.Bt = pws(p) + OFF_WPR + l * SZ_WPR;
        EpiDual E; E.merged = (bf16_t*)(pws(p) + OFF_MERGED); E.zb = (const bf16_t*)(pws(p) + OFF_ZB);
        { const int sidx = bid < 40 ? bid : (bid < 80 ? bid - 40 : 0); E.m1 = (float*)(pws(p) + OFF_M1) + ((size_t)l * 40 + sidx) * 65536; E.flag = (unsigned*)(pws(p) + OFF_BAR + 16384) + (l * 40 + sidx) * 64; }
        gemm_phase(lds, S, E, D, D, D, tid);
        if (l == 0 && bid >= 80) for (int it = bid - 80; it < 1440; it += G - 80) conv_item(p, 1, it, lds, launder(tid)); }
    } else { if (PH_MASK & 64) {
        SchedPlain S; S.init(MPAD, D, G, bid); S.A = pws(p) + OFF_MERGED; S.Bt = pws(p) + OFF_WOUT + l * SZ_WOUT; S.tstepA = (size_t)256 * D * 2; S.tstepB = (size_t)256 * D * 2;
        EpiOut E; E.xf = (float*)(pws(p) + OFF_XF); E.xb = (bf16_t*)(pws(p) + OFF_XB); E.rsq_next = l == 0 ? (float*)(pws(p) + OFF_RSQ) + MPAD : nullptr;
        gemm_phase(lds, S, E, D, D, D, tid);
        if (l == 0 && bid >= 40) for (int it = 1440 + bid - 40; it < 2880; it += G - 40) conv_item(p, 1, it, lds, launder(tid)); }
    }
}

#define XB_TMO      128
#define XB_XCNT(j)  (256  + 64 * (j))
#define XB_XSUB(j)  (1280 + 64 * (j))
#define XB_XGEN(j)  (2304 + 64 * (j))
#define XB_TOP      3328
#define XB_TOPGEN   3392
#define XCD_BAR_WORDS 3456
#define XB_SPIN_CAP (1u << 18)
__device__ __forceinline__ unsigned xb_ld(unsigned* p)              { return __hip_atomic_load(p, __ATOMIC_RELAXED, __HIP_MEMORY_SCOPE_AGENT); }
__device__ __forceinline__ unsigned xb_add(unsigned* p, unsigned v) { return __hip_atomic_fetch_add(p, v, __ATOMIC_RELAXED, __HIP_MEMORY_SCOPE_AGENT); }
__device__ __forceinline__ unsigned xb_xcc_id() { return (unsigned)__builtin_amdgcn_s_getreg((3 << 11) | 20) & 0xFu; }
#define XB_SPIN(cond, bar) do { unsigned _sp = 0; while (cond) { __builtin_amdgcn_s_sleep(1); \
    if ((++_sp & 255u) == 0u) { if (xb_ld(&(bar)[XB_TMO])) break; if (_sp > XB_SPIN_CAP) { atomicAdd(&(bar)[XB_TMO], 1u); break; } } } } while (0)
struct XcdBarrier { unsigned* bar; unsigned x; volatile LAS unsigned* st; };
__device__ __forceinline__ XcdBarrier xcd_barrier_post(unsigned* bar, volatile LAS unsigned* st) {
    XcdBarrier b; b.bar = bar; b.x = xb_xcc_id(); b.st = st;
    if (threadIdx.x == 0) (void)xb_add(&bar[XB_XCNT(b.x)], 1u);
    return b;
}
__device__ __forceinline__ void xcd_barrier_complete(unsigned* bar, unsigned x, unsigned& nloc, unsigned& nx) {
    const unsigned G = gridDim.x * gridDim.y * gridDim.z;
    unsigned sum, cnt, mine, sp = 0u;
    for (;;) {
        sum = 0u; cnt = 0u; mine = 0u;
#pragma unroll
        for (unsigned j = 0; j < 16; ++j) { const unsigned c = xb_ld(&bar[XB_XCNT(j)]); sum += c; cnt += (c > 0u) ? 1u : 0u; mine = (j == x) ? c : mine; }
        if (sum == G) break;
        __builtin_amdgcn_s_sleep(1);
        if ((++sp & 255u) == 0u) { if (xb_ld(&bar[XB_TMO])) break; if (sp > XB_SPIN_CAP) { atomicAdd(&bar[XB_TMO], 1u); break; } }
    }
    nloc = mine > 0u ? mine : 1u; nx = cnt > 0u ? cnt : 1u;
}
__device__ __forceinline__ void xcd_barrier(unsigned* bar_in, LAS unsigned char* lds_in) {
    XcdBarrier b; b.bar = bar_in; b.x = xb_xcc_id(); b.st = (volatile LAS unsigned*)(lds_in + LDS_ST_OFF);
    asm volatile("s_waitcnt vmcnt(0)" ::: "memory");
    __syncthreads();
    if (threadIdx.x == 0) {
        unsigned* bar = b.bar;
        __builtin_amdgcn_s_waitcnt(0);
        unsigned nloc = b.st[0], nx = b.st[1];
        if (nloc == 0u) { xcd_barrier_complete(bar, b.x, nloc, nx); b.st[0] = nloc; b.st[1] = nx; }
        const unsigned old = xb_add(&bar[XB_XSUB(b.x)], 1u);
        const unsigned gen = old / nloc;
        if (old + 1u == (gen + 1u) * nloc) {
            __builtin_amdgcn_fence(__ATOMIC_RELEASE, "agent");
            asm volatile("s_waitcnt vmcnt(0)" ::: "memory");
            const unsigned og = xb_add(&bar[XB_TOP], 1u);
            const unsigned tg = og / nx;
            if (og + 1u == (tg + 1u) * nx) xb_add(&bar[XB_TOPGEN], 1u);
            else XB_SPIN(xb_ld(&bar[XB_TOPGEN]) == tg, bar);
            __builtin_amdgcn_fence(__ATOMIC_ACQUIRE, "agent");
            xb_add(&bar[XB_XGEN(b.x)], 1u);
            asm volatile("s_waitcnt vmcnt(0)" ::: "memory");
        } else {
            XB_SPIN(xb_ld(&bar[XB_XGEN(b.x)]) == gen, bar);
            __builtin_amdgcn_fence(__ATOMIC_ACQUIRE, "agent");
            asm volatile("s_waitcnt vmcnt(0)" ::: "memory");
        }
    }
    __syncthreads();
}

extern __shared__ __attribute__((aligned(16))) unsigned char smem_dyn[];

#if MULTI
__global__ void __launch_bounds__(512, 2) phase_kernel(Params p, int ph) {
    int tid = threadIdx.x; asm volatile("" : "+v"(tid));
    int bid = blockIdx.x; asm volatile("" : "+s"(bid));
    run_phase(p, ph, (LAS unsigned char*)smem_dyn, tid, bid);
}
#else
__global__ void __launch_bounds__(512, 2) mega_kernel(Params p, unsigned* bar) {
    cg::grid_group grid = cg::this_grid();
    LAS unsigned char* lds = (LAS unsigned char*)smem_dyn;
#ifndef REPEAT_SUB
#define REPEAT_SUB -1
#endif
    volatile LAS unsigned* st = (volatile LAS unsigned*)(lds + LDS_ST_OFF);
    if (threadIdx.x == 0) { st[0] = 0u; st[1] = 0u; }
    __syncthreads();
    (void)xcd_barrier_post(bar, st);
    int ph = 0, rep = 0;
#pragma unroll 1
    while (ph < 14) {
        int tid = threadIdx.x; asm volatile("" : "+v"(tid));
        int bid = blockIdx.x; asm volatile("" : "+s"(bid)); bid = __builtin_amdgcn_readfirstlane(bid);
        run_phase(p, ph, lds, tid, bid);
        if (ph == 0) grid.sync(); else if (ph < 13) xcd_barrier(bar, lds);
        const bool match = (REPEAT_SUB == 100) ? (ph == 0) : (ph >= 1 && ph <= 12 && ((ph - 1) % 6) == REPEAT_SUB);
        if (match && rep == 0) rep = 1; else { rep = 0; ++ph; }
    }
}
#endif

extern "C" void kernel_launch(void* const* d_in, const int* in_sizes, int n_in, void* d_out, int out_size, void* d_ws, size_t ws_size, hipStream_t stream) {
    Params p{};
    p.x_prompt = (const float*)d_in[0]; p.x_sample = (const float*)d_in[1]; p.state_pool = (const float*)d_in[2]; p.state_ret = (const float*)d_in[3];
    p.meta = (const float*)d_in[4]; p.norm_gain = (const float*)d_in[5]; p.w_in = (const float*)d_in[6]; p.pool_w = (const float*)d_in[7];
    p.pool_scale = (const float*)d_in[8]; p.ret_gn = (const float*)d_in[9]; p.proj_pool = (const float*)d_in[10]; p.proj_ret = (const float*)d_in[11];
    p.w_out = (const float*)d_in[12]; p.final_norm = (const float*)d_in[13];
    p.out = (float*)d_out; p.ws = (char*)d_ws;
    if (ws_size < WS_TOTAL) { fprintf(stderr, "workspace too small: %zu < %zu\n", ws_size, (size_t)WS_TOTAL); return; }
#if MULTI
    static bool attr_set = false;
    if (!attr_set) { hipFuncSetAttribute((const void*)phase_kernel, hipFuncAttributeMaxDynamicSharedMemorySize, LDS_BYTES); attr_set = true; }
    for (int ph = 0; ph < 14; ++ph) phase_kernel<<<dim3(256), dim3(512), LDS_BYTES, stream>>>(p, ph);
#else
    static int grid_blocks = 0;
    if (!grid_blocks) {
        hipFuncSetAttribute((const void*)mega_kernel, hipFuncAttributeMaxDynamicSharedMemorySize, LDS_BYTES);
        int dev = 0, cus = 0, per_cu = 0;
        hipGetDevice(&dev);
        hipDeviceGetAttribute(&cus, hipDeviceAttributeMultiprocessorCount, dev);
        hipOccupancyMaxActiveBlocksPerMultiprocessor(&per_cu, mega_kernel, 512, LDS_BYTES);
        if (per_cu > 1) per_cu = 1;
        grid_blocks = cus * per_cu;
    }
    (void)hipMemsetAsync((char*)d_ws + OFF_BAR, 0, 16384 + 32768, stream);
    unsigned* bar = (unsigned*)((char*)d_ws + OFF_BAR);
    void* args[] = {&p, &bar};
    hipError_t e = hipLaunchCooperativeKernel((void*)mega_kernel, dim3(grid_blocks), dim3(512), args, LDS_BYTES, stream);
    if (e != hipSuccess) fprintf(stderr, "cooperative launch failed: %s (grid %d)\n", hipGetErrorString(e), grid_blocks);
#endif
}
```

```cpp
#include <hip/hip_runtime.h>
#include <hip/hip_cooperative_groups.h>
#include <cstdio>
namespace cg = cooperative_groups;

#ifndef MULTI
#define MULTI 0
#endif

#define LAS __attribute__((address_space(3)))
typedef unsigned short bf16_t;
typedef short bf16x8 __attribute__((ext_vector_type(8)));
typedef short s16x4 __attribute__((ext_vector_type(4)));
typedef float f32x4 __attribute__((ext_vector_type(4)));
typedef unsigned u32x4 __attribute__((ext_vector_type(4)));
typedef unsigned u32x2 __attribute__((ext_vector_type(2)));

constexpr int D = 2048, NIN = 16384, ZW = 14336;
constexpr int MS = 1024, LP = 2064, MR = 9280, MPAD = 9472, NMT = 37;
constexpr int NPOS = 2072;
constexpr int LDS_BYTES = 147456;
constexpr float EPS = 1e-6f;
constexpr int ZC_PG = 0, ZC_Q = 2048, ZC_K = 4096, ZC_V = 6144, ZC_RG = 8192, ZC_GP = 10240, ZC_GR = 12288;
constexpr size_t SZ_WIN = (size_t)NIN * D * 2, SZ_WPOOL = (size_t)2048 * 512 * 2, SZ_WPR = (size_t)4096 * D * 2, SZ_WOUT = (size_t)D * D * 2;
constexpr size_t OFF_WIN = 0;
constexpr size_t OFF_WPOOL = OFF_WIN + 2 * SZ_WIN;
constexpr size_t OFF_WPR = OFF_WPOOL + 2 * SZ_WPOOL;
constexpr size_t OFF_WOUT = OFF_WPR + 2 * SZ_WPR;
constexpr size_t OFF_XF = OFF_WOUT + 2 * SZ_WOUT;
constexpr size_t OFF_XB = OFF_XF + (size_t)MPAD * D * 4;
constexpr size_t OFF_RSQ = OFF_XB + (size_t)MPAD * D * 2;
constexpr size_t OFF_U = OFF_RSQ + (size_t)MPAD * 32 * 4;
constexpr size_t OFF_ZB = OFF_U + (size_t)MPAD * D * 4;
constexpr size_t OFF_POOLED = OFF_ZB + (size_t)MPAD * ZW * 2;
constexpr size_t OFF_AIN = OFF_POOLED + (size_t)MPAD * D * 2;
constexpr size_t OFF_M1 = OFF_AIN + (size_t)2 * MPAD * D * 2;
constexpr size_t OFF_MERGED = OFF_M1 + (size_t)MPAD * D * 4;
constexpr size_t OFF_KV = OFF_MERGED + (size_t)MPAD * D * 2;
constexpr size_t OFF_SB = OFF_KV + (size_t)544 * 65536 * 4;
constexpr size_t OFF_CS = OFF_SB + (size_t)544 * 65536 * 2;
constexpr size_t OFF_BAR = OFF_CS + (size_t)NPOS * 128 * 8;
constexpr size_t WS_TOTAL = OFF_BAR + 16384 + 32768;
constexpr int LDS_ST_OFF = 147440;
constexpr size_t O_YP = 0, O_YS = 16777216, O_PP = O_YS + 2097152, O_RP = O_PP + 245760, O_PS = O_RP + 4194304, O_RS = O_PS + 7864320;

struct Params {
    const float *x_prompt, *x_sample, *state_pool, *state_ret, *meta, *norm_gain, *w_in, *pool_w, *pool_scale, *ret_gn, *proj_pool, *proj_ret, *w_out, *final_norm;
    float* out;
    char* ws;
};

__device__ __forceinline__ char* pws(const Params& p) { return p.ws; }
__device__ __forceinline__ float* pout(const Params& p) { return p.out; }
__device__ __forceinline__ unsigned pk_bf16(float lo, float hi) { unsigned r; asm volatile("v_cvt_pk_bf16_f32 %0, %1, %2" : "=v"(r) : "v"(lo), "v"(hi)); return r; }
__device__ __forceinline__ float bf_lo(unsigned u) { return __uint_as_float(u << 16); }
__device__ __forceinline__ float bf_hi(unsigned u) { return __uint_as_float(u & 0xffff0000u); }
__device__ __forceinline__ float dpp_f(float v, const int ctrl_sel) {
    const int x = __builtin_bit_cast(int, v); int r;
    if (ctrl_sel == 0) r = __builtin_amdgcn_update_dpp(0, x, 0xB1, 0xF, 0xF, true);
    else if (ctrl_sel == 1) r = __builtin_amdgcn_update_dpp(0, x, 0x4E, 0xF, 0xF, true);
    else if (ctrl_sel == 2) r = __builtin_amdgcn_update_dpp(0, x, 0x141, 0xF, 0xF, true);
    else r = __builtin_amdgcn_update_dpp(0, x, 0x140, 0xF, 0xF, true);
    return __builtin_bit_cast(float, r);
}
__device__ __forceinline__ float wave_sum(float v) {
    v += dpp_f(v, 0); v += dpp_f(v, 1); v += dpp_f(v, 2); v += dpp_f(v, 3);
    const int x = __builtin_bit_cast(int, v);
    const float a = __builtin_bit_cast(float, __builtin_amdgcn_readlane(x, 0)), b = __builtin_bit_cast(float, __builtin_amdgcn_readlane(x, 16));
    const float c = __builtin_bit_cast(float, __builtin_amdgcn_readlane(x, 32)), d = __builtin_bit_cast(float, __builtin_amdgcn_readlane(x, 48));
    return (a + b) + (c + d);
}
__device__ __forceinline__ int launder(int v) { asm volatile("" : "+v"(v)); return v; }
__device__ __forceinline__ float lg2gamma(int h) { return log1pf(-exp2f(-5.0f - (float)h)) * 1.4426950408889634f; }
__device__ __forceinline__ float sigmoidf_(float x) { return __builtin_amdgcn_rcpf(1.0f + __expf(-x)); }
__device__ __forceinline__ float siluf_(float x) { return x * sigmoidf_(x); }

constexpr int BM = 256, BK = 64, HALF = 128, HTB = HALF * BK * 2, NXCD = 8, WGM = 8;
__device__ __forceinline__ int lds_byte(int r, int c) { const int st = (r >> 4) * 2 + (c >> 5), rr = r & 15, cc = c & 31, ob = rr * 64 + cc * 2; return st * 1024 + (ob ^ (((ob >> 9) & 1) << 5)); }
__device__ __forceinline__ void stage_rc(int b, int& R, int& C) { const int st = b / 1024, sb = b % 1024, swz = sb ^ (((sb >> 9) & 1) << 5); R = (st >> 1) * 16 + swz / 64; C = (st & 1) * 32 + (swz % 64) / 2; }
__device__ __forceinline__ int perm32(int rho) { const int n = rho >> 4, i = rho & 15; return 8 * (i >> 2) + 4 * n + (i & 3); }

struct Unit { int pm, pn, mode; };
struct StaticOrder {
    int nM, nN, nwg, G, c;
    __device__ void init(int M, int N, int G_, int c_) { nM = M / BM; nN = N / BM; nwg = nM * nN; G = G_; c = c_; }
    __device__ bool next(int i, Unit& u) const {
        const long L = (long)i * G + c; if (L >= nwg) return false;
        int wgid = (int)L; { const int q = nwg / NXCD, r = nwg % NXCD, xcd = wgid % NXCD, off = wgid / NXCD; wgid = (xcd < r ? xcd * (q + 1) : r * (q + 1) + (xcd - r) * q) + off; }
        const int nig = WGM * nN, gid = wgid / nig, fm = gid * WGM, gsz = (nM - fm) < WGM ? (nM - fm) : WGM;
        u.pm = fm + ((wgid % nig) % gsz); u.pn = (wgid % nig) / gsz; u.mode = 0; return true;
    }
};

template <class Epi, class Sched>
__device__ __forceinline__ void gemm_phase(LAS unsigned char* lds, const Sched& S, const Epi& E, const int K, const int lda, const int ldb, const int tid) {
    const int wid = __builtin_amdgcn_readfirstlane(tid >> 6), lane = tid & 63, wr = wid >> 2, wc = wid & 3, fr = lane & 15, fq = lane >> 4;
    const int nt = K / BK;
    unsigned voffA[2], voffB[2];
#pragma unroll
    for (int i = 0; i < 2; ++i) { int R, C; stage_rc(tid * 16 + i * 8192, R, C); const int Rb = (R & ~31) + perm32(R & 31);
        voffA[i] = (unsigned)(R * lda + C) * 2u; voffB[i] = (unsigned)(Rb * ldb + C) * 2u; }
    const size_t kstep = (size_t)(BK * 2);
    const size_t hstepA = (size_t)HALF * lda * 2, hstepB = (size_t)HALF * ldb * 2;
    const unsigned ldsw = (unsigned)wid * 1024u;
    const int aoff = lds_byte(wr * 64 + fr, fq * 8), boff = lds_byte(wc * 32 + fr, fq * 8);
#define G_SA(b, h) (((b) * 2 + (h)) * HTB)
#define G_SB(b, h) ((4 + (b) * 2 + (h)) * HTB)
#define G_STAGE(bufoff, gbase, voff) do { _Pragma("unroll") for (int _i = 0; _i < 2; ++_i) \
        __builtin_amdgcn_global_load_lds((const unsigned*)((const char*)(gbase) + (voff)[_i]), (LAS unsigned*)(lds + (bufoff) + ldsw + _i * 8192), 16, 0, 0); } while (0)
#define G_LDA(dst, b, h) do { _Pragma("unroll") for (int m = 0; m < 4; ++m) _Pragma("unroll") for (int k = 0; k < 2; ++k) dst[m][k] = *(const LAS bf16x8*)(lds + G_SA(b, h) + aoff + m * 2048 + k * 1024); } while (0)
#define G_LDB(dst, b, h) do { _Pragma("unroll") for (int n = 0; n < 2; ++n) _Pragma("unroll") for (int k = 0; k < 2; ++k) dst[n][k] = *(const LAS bf16x8*)(lds + G_SB(b, h) + boff + n * 2048 + k * 1024); } while (0)
#define G_MMA(ai, bj, At, Bt) do { __builtin_amdgcn_s_setprio(1); _Pragma("unroll") for (int m = 0; m < 4; ++m) _Pragma("unroll") for (int n = 0; n < 2; ++n) _Pragma("unroll") for (int k = 0; k < 2; ++k) \
        acc[ai][bj][m][n] = __builtin_amdgcn_mfma_f32_16x16x32_bf16(Bt[n][k], At[m][k], acc[ai][bj][m][n], 0, 0, 0); __builtin_amdgcn_s_setprio(0); } while (0)
#define G_WAIT_V(n) asm volatile("s_waitcnt vmcnt(" #n ")" ::: "memory")
#define G_WAIT_L(n) asm volatile("s_waitcnt lgkmcnt(" #n ")" ::: "memory")
#define G_BAR __builtin_amdgcn_s_barrier()
#define G_SCHED __builtin_amdgcn_sched_barrier(0)
    Unit cur, nxt; int ui = 0;
    if (!S.next(0, cur)) return;
    f32x4 acc[2][2][4][2];
#pragma unroll
    for (int a = 0; a < 2; ++a)
#pragma unroll
        for (int b = 0; b < 2; ++b)
#pragma unroll
            for (int m = 0; m < 4; ++m)
#pragma unroll
                for (int n = 0; n < 2; ++n) acc[a][b][m][n] = (f32x4){0.f, 0.f, 0.f, 0.f};
    bf16x8 At[4][2], B0[2][2], B1[2][2];
    const char* cA; const char* cB; S.ptrs(cur, cA, cB);
    G_STAGE(G_SB(0, 0), cB, voffB); G_STAGE(G_SA(0, 0), cA, voffA); G_STAGE(G_SB(0, 1), cB + hstepB, voffB); G_STAGE(G_SA(0, 1), cA + hstepA, voffA);
    if (wr == 1) G_BAR;
    G_WAIT_V(4); G_BAR;
    G_STAGE(G_SB(1, 0), cB + kstep, voffB); G_STAGE(G_SA(1, 0), cA + kstep, voffA); G_STAGE(G_SB(1, 1), cB + hstepB + kstep, voffB);
    G_WAIT_V(6); G_BAR;
    for (;;) {
        const bool has_next = S.next(ui + 1, nxt);
        const char* nA = cA; const char* nB = cB; if (has_next) S.ptrs(nxt, nA, nB);
        for (int t = 0; t < nt; t += 2) {
            const bool last = (t == nt - 2);
            const char* a1 = cA + (size_t)(t + 1) * kstep;
            const char* a2 = last ? nA : cA + (size_t)(t + 2) * kstep; const char* b2 = last ? nB : cB + (size_t)(t + 2) * kstep;
            const char* a3 = a2 + kstep; const char* b3 = b2 + kstep;
            G_LDB(B0, 0, 0); G_SCHED; G_LDA(At, 0, 0); G_STAGE(G_SA(1, 1), a1 + hstepA, voffA);
            G_WAIT_L(8); G_BAR; G_WAIT_L(0); G_MMA(0, 0, At, B0); G_BAR; G_SCHED;
            G_LDB(B1, 0, 1); G_STAGE(G_SB(0, 0), b2, voffB);
            G_BAR; G_WAIT_L(0); G_MMA(0, 1, At, B1); G_BAR;
            G_LDA(At, 0, 1); G_STAGE(G_SA(0, 0), a2, voffA);
            G_BAR; G_WAIT_L(0); G_MMA(1, 0, At, B0); G_BAR; G_SCHED;
            G_STAGE(G_SB(0, 1), b2 + hstepB, voffB);
            G_WAIT_V(6); G_BAR; G_MMA(1, 1, At, B1); G_BAR;
            G_LDB(B0, 1, 0); G_SCHED; G_LDA(At, 1, 0); G_STAGE(G_SA(0, 1), a2 + hstepA, voffA);
            G_WAIT_L(8); G_BAR; G_WAIT_L(0); G_MMA(0, 0, At, B0); G_BAR; G_SCHED;
            G_LDB(B1, 1, 1); G_STAGE(G_SB(1, 0), b3, voffB);
            G_BAR; G_WAIT_L(0); G_MMA(0, 1, At, B1); G_BAR;
            G_LDA(At, 1, 1); G_STAGE(G_SA(1, 0), a3, voffA);
            G_BAR; G_WAIT_L(0); G_MMA(1, 0, At, B0); G_BAR; G_SCHED;
            G_STAGE(G_SB(1, 1), b3 + hstepB, voffB);
            G_WAIT_V(6); G_BAR; G_MMA(1, 1, At, B1); G_BAR;
        }
        const bool keep = E(acc, cur, wr, wc, fr, fq);
        if (!has_next) break;
        if (!keep)
#pragma unroll
        for (int a = 0; a < 2; ++a)
#pragma unroll
            for (int b = 0; b < 2; ++b)
#pragma unroll
                for (int m = 0; m < 4; ++m)
#pragma unroll
                    for (int n = 0; n < 2; ++n) acc[a][b][m][n] = (f32x4){0.f, 0.f, 0.f, 0.f};
        cur = nxt; cA = nA; cB = nB; ++ui;
    }
    G_WAIT_V(0);
    if (wr == 0) G_BAR;
    G_BAR;
#undef G_SA
#undef G_SB
#undef G_STAGE
#undef G_LDA
#undef G_LDB
#undef G_MMA
#undef G_WAIT_V
#undef G_WAIT_L
#undef G_BAR
#undef G_SCHED
}

struct SchedPlain : StaticOrder {
    const char* A; const char* Bt; size_t tstepA, tstepB;
    __device__ __forceinline__ void ptrs(const Unit& u, const char*& a, const char*& b) const { a = A + (size_t)u.pm * tstepA; b = Bt + (size_t)u.pn * tstepB; }
};
struct SchedPool : StaticOrder {
    const char* A; const char* Bt;
    __device__ __forceinline__ void ptrs(const Unit& u, const char*& a, const char*& b) const {
        a = A + ((size_t)u.pm * 256 * D + (size_t)(u.pn >> 1) * 512) * 2; b = Bt + (size_t)u.pn * 256 * 512 * 2; }
};
struct SchedDual : StaticOrder {
    const char* A; const char* Bt;
    __device__ bool next(int i, Unit& u) const {
        if (i < 2) { if (!StaticOrder::next(0, u)) return false; u.mode = i; return true; }
        if (i == 2 && c < 80) { StaticOrder t = *this; t.c = c < 40 ? c : c - 40; if (!t.next(1, u)) return false; u.mode = c < 40 ? 2 : 3; return true; }
        return false;
    }
    __device__ __forceinline__ void ptrs(const Unit& u, const char*& a, const char*& b) const {
        a = A + (size_t)((u.mode & 1) * NMT + u.pm) * 256 * D * 2; b = Bt + (size_t)((u.mode & 1) * 8 + u.pn) * 256 * D * 2; }
};

struct EpiWin {
    float* u; bf16_t* zb; const float* rsq; const float* cf;
    template <int KIND>
    __device__ __forceinline__ void body(f32x4 (&acc)[2][2][4][2], const Unit& un, int wr, int wc, int fr, int fq) const {
        const int sec = un.pn >> 3, colt = (un.pn & 7) * 256, cw = wc * 32 + 8 * fq;
        const int rbase = un.pm * 256 + wr * 64 + fr;
        float rstd[8];
#pragma unroll
        for (int i = 0; i < 8; ++i) rstd[i] = rsq[rbase + (i >> 2) * 128 + (i & 3) * 16];
        f32x4 cfv[4];
        if (KIND == 2 || KIND == 3) {
#pragma unroll
            for (int t = 0; t < 4; ++t) cfv[t] = *(const f32x4*)(cf + (size_t)cw * 2 + t * 4);
        }
#pragma unroll
        for (int i = 0; i < 8; ++i) rstd[i] = rsqrtf(rstd[i] * (1.0f / 2048.0f) + EPS);
#pragma unroll
        for (int ai = 0; ai < 2; ++ai)
#pragma unroll
            for (int m = 0; m < 4; ++m) {
                const int r = rbase + ai * 128 + m * 16;
                const float rs = rstd[ai * 4 + m];
                f32x4 v[2][2];
#pragma unroll
                for (int bj = 0; bj < 2; ++bj)
#pragma unroll
                    for (int n = 0; n < 2; ++n) v[bj][n] = acc[ai][bj][m][n] * rs;
                if (KIND == 0) {
                    float* up = u + (size_t)r * D + colt + cw;
#pragma unroll
                    for (int bj = 0; bj < 2; ++bj)
#pragma unroll
                        for (int n = 0; n < 2; ++n) *(f32x4*)(up + bj * 128 + 4 * n) = v[bj][n];
                } else {
                    if (KIND == 2 || KIND == 3) {
                        const float pos = r < MS ? (float)(16384 + (r & 7)) : (float)((r - MS) % LP);
                        const float sc = KIND == 3 ? 0.0625f : 1.0f;
#pragma unroll
                        for (int n = 0; n < 2; ++n)
#pragma unroll
                            for (int j = 0; j < 4; ++j) {
                                const int t = 4 * n + j; const float chi = cfv[t >> 1][(t & 1) * 2], clo = cfv[t >> 1][(t & 1) * 2 + 1];
                                const float pp = pos * chi, ee = fmaf(pos, chi, -pp);
                                const float rev = (pp - rintf(pp)) + fmaf(pos, clo, ee);
                                const float cc = __builtin_amdgcn_cosf(rev) * sc, ss = __builtin_amdgcn_sinf(rev) * sc;
                                const float t1 = v[0][n][j], t2 = v[1][n][j];
                                v[0][n][j] = t1 * cc - t2 * ss; v[1][n][j] = t2 * cc + t1 * ss; }
                    } else if (KIND == 1) {
#pragma unroll
                        for (int bj = 0; bj < 2; ++bj)
#pragma unroll
                            for (int n = 0; n < 2; ++n)
#pragma unroll
                                for (int j = 0; j < 4; ++j) v[bj][n][j] = siluf_(v[bj][n][j]);
                    } else if (KIND == 5) {
#pragma unroll
                        for (int bj = 0; bj < 2; ++bj)
#pragma unroll
                            for (int n = 0; n < 2; ++n)
#pragma unroll
                                for (int j = 0; j < 4; ++j) v[bj][n][j] = sigmoidf_(v[bj][n][j]);
                    }
                    bf16_t* zp = zb + (size_t)r * ZW + (size_t)(sec - 1) * 2048 + colt + cw;
#pragma unroll
                    for (int bj = 0; bj < 2; ++bj) { u32x4 w; w.x = pk_bf16(v[bj][0][0], v[bj][0][1]); w.y = pk_bf16(v[bj][0][2], v[bj][0][3]); w.z = pk_bf16(v[bj][1][0], v[bj][1][1]); w.w = pk_bf16(v[bj][1][2], v[bj][1][3]);
                        *(u32x4*)(zp + bj * 128) = w; }
                }
            }
    }
    __device__ __forceinline__ bool operator()(f32x4 (&acc)[2][2][4][2], const Unit& un, int wr, int wc, int fr, int fq) const {
        const int sec = un.pn >> 3;
        if (sec == 0) body<0>(acc, un, wr, wc, fr, fq);
        else if (sec == 1 || sec == 5) body<1>(acc, un, wr, wc, fr, fq);
        else if (sec == 2) body<2>(acc, un, wr, wc, fr, fq);
        else if (sec == 3) body<3>(acc, un, wr, wc, fr, fq);
        else if (sec == 4) body<4>(acc, un, wr, wc, fr, fq);
        else body<5>(acc, un, wr, wc, fr, fq);
        return false;
    }
};

struct EpiPool {
    bf16_t* ain; const bf16_t* zb;
    __device__ __forceinline__ bool operator()(f32x4 (&acc)[2][2][4][2], const Unit& un, int wr, int wc, int fr, int fq) const {
        const int c0 = un.pn * 256 + wc * 32 + 8 * fq;
        const int rbase = un.pm * 256 + wr * 64 + fr;
        u32x4 g[2][4][2];
#pragma unroll
        for (int ai = 0; ai < 2; ++ai)
#pragma unroll
            for (int m = 0; m < 4; ++m)
#pragma unroll
                for (int bj = 0; bj < 2; ++bj) g[ai][m][bj] = *(const u32x4*)(zb + (size_t)(rbase + ai * 128 + m * 16) * ZW + ZC_PG + c0 + bj * 128);
#pragma unroll
        for (int ai = 0; ai < 2; ++ai)
#pragma unroll
            for (int m = 0; m < 4; ++m) {
                const int r = rbase + ai * 128 + m * 16;
#pragma unroll
                for (int bj = 0; bj < 2; ++bj) {
                    const u32x4 gg = g[ai][m][bj];
                    const f32x4 v0 = acc[ai][bj][m][0], v1 = acc[ai][bj][m][1];
                    u32x4 w;
                    w.x = pk_bf16(v0[0] * bf_lo(gg.x), v0[1] * bf_hi(gg.x)); w.y = pk_bf16(v0[2] * bf_lo(gg.y), v0[3] * bf_hi(gg.y));
                    w.z = pk_bf16(v1[0] * bf_lo(gg.z), v1[1] * bf_hi(gg.z)); w.w = pk_bf16(v1[2] * bf_lo(gg.w), v1[3] * bf_hi(gg.w));
                    *(u32x4*)(ain + (size_t)r * D + c0 + bj * 128) = w;
                }
            }
        return false;
    }
};

struct EpiDual {
    bf16_t* merged; const bf16_t* zb; float* m1; unsigned* flag;
    __device__ __forceinline__ bool operator()(f32x4 (&acc)[2][2][4][2], const Unit& un, int wr, int wc, int fr, int fq) const {
        const int mode = un.mode;
        const int c0 = un.pn * 256 + wc * 32 + 8 * fq;
        const int rbase = un.pm * 256 + wr * 64 + fr;
        float* m1w = m1 + (size_t)(wr * 4 + wc) * 128 * 64 + launder(fq * 16 + fr);
        if (!(mode & 1)) {
#pragma unroll
            for (int ai = 0; ai < 2; ++ai)
#pragma unroll
            for (int mh = 0; mh < 2; ++mh) {
                u32x4 gp[2][2], gr[2][2];
#pragma unroll
                for (int m = 0; m < 2; ++m)
#pragma unroll
                    for (int bj = 0; bj < 2; ++bj) { const bf16_t* zp = zb + (size_t)(rbase + ai * 128 + (mh * 2 + m) * 16) * ZW + c0 + bj * 128;
                        gp[m][bj] = *(const u32x4*)(zp + ZC_GP); gr[m][bj] = *(const u32x4*)(zp + ZC_GR); }
#pragma unroll
                for (int m = 0; m < 2; ++m)
#pragma unroll
                    for (int bj = 0; bj < 2; ++bj) {
                        const u32x4 a = gp[m][bj], b = gr[m][bj];
                        f32x4& v0 = acc[ai][bj][mh * 2 + m][0]; f32x4& v1 = acc[ai][bj][mh * 2 + m][1];
                        if (mode == 0) {
                            v0[0] *= bf_lo(a.x) * __builtin_amdgcn_rcpf(bf_lo(b.x)); v0[1] *= bf_hi(a.x) * __builtin_amdgcn_rcpf(bf_hi(b.x));
                            v0[2] *= bf_lo(a.y) * __builtin_amdgcn_rcpf(bf_lo(b.y)); v0[3] *= bf_hi(a.y) * __builtin_amdgcn_rcpf(bf_hi(b.y));
                            v1[0] *= bf_lo(a.z) * __builtin_amdgcn_rcpf(bf_lo(b.z)); v1[1] *= bf_hi(a.z) * __builtin_amdgcn_rcpf(bf_hi(b.z));
                            v1[2] *= bf_lo(a.w) * __builtin_amdgcn_rcpf(bf_lo(b.w)); v1[3] *= bf_hi(a.w) * __builtin_amdgcn_rcpf(bf_hi(b.w));
                        } else {
                            v0[0] *= bf_lo(a.x); v0[1] *= bf_hi(a.x); v0[2] *= bf_lo(a.y); v0[3] *= bf_hi(a.y);
                            v1[0] *= bf_lo(a.z); v1[1] *= bf_hi(a.z); v1[2] *= bf_lo(a.w); v1[3] *= bf_hi(a.w);
                        }
                    }
            }
            if (mode == 0) return true;
#pragma unroll
            for (int ai = 0; ai < 2; ++ai)
#pragma unroll
                for (int bj = 0; bj < 2; ++bj)
#pragma unroll
                    for (int m = 0; m < 4; ++m)
#pragma unroll
                        for (int n = 0; n < 2; ++n)
#pragma unroll
                            for (int e = 0; e < 4; ++e) __hip_atomic_store(m1w + (((((ai * 2 + bj) * 4 + m) * 2 + n) * 4 + e) * 64), acc[ai][bj][m][n][e], __ATOMIC_RELAXED, __HIP_MEMORY_SCOPE_AGENT);
            asm volatile("s_waitcnt vmcnt(0)" ::: "memory");
            __builtin_amdgcn_fence(__ATOMIC_RELEASE, "agent");
            asm volatile("s_waitcnt vmcnt(0)" ::: "memory");
            if (fr == 0 && fq == 0) __hip_atomic_fetch_add(flag, 1u, __ATOMIC_RELAXED, __HIP_MEMORY_SCOPE_AGENT);
            return false;
        }
        if (mode == 3) {
            unsigned sp = 0;
            while (__hip_atomic_load(flag, __ATOMIC_RELAXED, __HIP_MEMORY_SCOPE_AGENT) < 8u) { __builtin_amdgcn_s_sleep(2); if (++sp > (1u << 22)) break; }
            __builtin_amdgcn_fence(__ATOMIC_ACQUIRE, "agent");
            asm volatile("s_waitcnt vmcnt(0)" ::: "memory");
#pragma unroll
            for (int ai = 0; ai < 2; ++ai)
#pragma unroll
                for (int bj = 0; bj < 2; ++bj) {
                    u32x4 gr[4]; f32x4 mv[4][2];
#pragma unroll
                    for (int m = 0; m < 4; ++m) { gr[m] = *(const u32x4*)(zb + (size_t)(rbase + ai * 128 + m * 16) * ZW + ZC_GR + c0 + bj * 128);
#pragma unroll
                        for (int n = 0; n < 2; ++n)
#pragma unroll
                            for (int e = 0; e < 4; ++e) mv[m][n][e] = __hip_atomic_load(m1w + (((((ai * 2 + bj) * 4 + m) * 2 + n) * 4 + e) * 64), __ATOMIC_RELAXED, __HIP_MEMORY_SCOPE_AGENT); }
#pragma unroll
                    for (int m = 0; m < 4; ++m) {
                        const int r = rbase + ai * 128 + m * 16;
                        const u32x4 b = gr[m];
                        f32x4 v0 = acc[ai][bj][m][0], v1 = acc[ai][bj][m][1];
                        v0[0] *= bf_lo(b.x); v0[1] *= bf_hi(b.x); v0[2] *= bf_lo(b.y); v0[3] *= bf_hi(b.y);
                        v1[0] *= bf_lo(b.z); v1[1] *= bf_hi(b.z); v1[2] *= bf_lo(b.w); v1[3] *= bf_hi(b.w);
                        v0 += mv[m][0]; v1 += mv[m][1];
                        u32x4 w; w.x = pk_bf16(v0[0], v0[1]); w.y = pk_bf16(v0[2], v0[3]); w.z = pk_bf16(v1[0], v1[1]); w.w = pk_bf16(v1[2], v1[3]);
                        *(u32x4*)(merged + (size_t)r * D + c0 + bj * 128) = w;
                    }
                }
            return false;
        }
        u32x4 gr[2][4][2];
#pragma unroll
        for (int ai = 0; ai < 2; ++ai)
#pragma unroll
            for (int m = 0; m < 4; ++m)
#pragma unroll
                for (int bj = 0; bj < 2; ++bj) gr[ai][m][bj] = *(const u32x4*)(zb + (size_t)(rbase + ai * 128 + m * 16) * ZW + ZC_GR + c0 + bj * 128);
#pragma unroll
        for (int ai = 0; ai < 2; ++ai)
#pragma unroll
            for (int m = 0; m < 4; ++m) {
                const int r = rbase + ai * 128 + m * 16;
#pragma unroll
                for (int bj = 0; bj < 2; ++bj) {
                    const u32x4 b = gr[ai][m][bj];
                    const f32x4 v0 = acc[ai][bj][m][0], v1 = acc[ai][bj][m][1];
                    u32x4 w; w.x = pk_bf16(v0[0] * bf_lo(b.x), v0[1] * bf_hi(b.x)); w.y = pk_bf16(v0[2] * bf_lo(b.y), v0[3] * bf_hi(b.y));
                    w.z = pk_bf16(v1[0] * bf_lo(b.z), v1[1] * bf_hi(b.z)); w.w = pk_bf16(v1[2] * bf_lo(b.w), v1[3] * bf_hi(b.w));
                    *(u32x4*)(merged + (size_t)r * D + c0 + bj * 128) = w;
                }
            }
        return false;
    }
};

struct EpiOut {
    float* xf; bf16_t* xb; float* rsq_next;
    __device__ __forceinline__ bool operator()(f32x4 (&acc)[2][2][4][2], const Unit& un, int wr, int wc, int fr, int fq) const {
        const int c0 = un.pn * 256 + wc * 32 + 8 * fq;
        const int rbase = un.pm * 256 + wr * 64 + fr;
#pragma unroll
        for (int ai = 0; ai < 2; ++ai) {
            f32x4 xv[4][2][2];
#pragma unroll
            for (int m = 0; m < 4; ++m)
#pragma unroll
                for (int bj = 0; bj < 2; ++bj) { const float* xp = xf + (size_t)(rbase + ai * 128 + m * 16) * D + c0 + bj * 128;
                    xv[m][bj][0] = *(const f32x4*)xp; xv[m][bj][1] = *(const f32x4*)(xp + 4); }
#pragma unroll
            for (int m = 0; m < 4; ++m) {
                const int r = rbase + ai * 128 + m * 16;
                float ssq = 0.f;
#pragma unroll
                for (int bj = 0; bj < 2; ++bj) {
                    float* xp = xf + (size_t)r * D + c0 + bj * 128;
                    const f32x4 v0 = xv[m][bj][0] + acc[ai][bj][m][0], v1 = xv[m][bj][1] + acc[ai][bj][m][1];
                    *(f32x4*)xp = v0; *(f32x4*)(xp + 4) = v1;
                    u32x4 w; w.x = pk_bf16(v0[0], v0[1]); w.y = pk_bf16(v0[2], v0[3]); w.z = pk_bf16(v1[0], v1[1]); w.w = pk_bf16(v1[2], v1[3]);
                    *(u32x4*)(xb + (size_t)r * D + c0 + bj * 128) = w;
#pragma unroll
                    for (int j = 0; j < 4; ++j) ssq += v0[j] * v0[j] + v1[j] * v1[j];
                }
                if (rsq_next) atomicAdd(rsq_next + r, ssq);
            }
        }
        return false;
    }
};

__device__ __forceinline__ int swz(int row) { return ((row & 3) << 2) | ((row >> 2) & 3); }
__device__ __forceinline__ int img_off(int row, int col) {
    const int sub = col >> 7, cc = col & 127;
    return sub * 32768 + 256 * row + 16 * ((cc >> 3) ^ swz(row)) + (cc & 7) * 2;
}
__device__ __forceinline__ bf16x8 frag_direct(LAS unsigned char* base, int r0, int k0, int lane) {
    return *(const LAS bf16x8*)(base + img_off(r0 + (lane & 15), k0 + 8 * (lane >> 4)));
}
__device__ __forceinline__ bf16x8 frag_tr(LAS unsigned char* base, int k0, int c0, int lane) {
    const int g = lane >> 4, q = (lane >> 2) & 3, p = lane & 3;
    const int row = k0 + 8 * g + q, col = c0 + 4 * p;
    const s16x4 lo = __builtin_amdgcn_ds_read_tr16_b64_v4i16((LAS s16x4*)(base + img_off(row, col)));
    const s16x4 hi = __builtin_amdgcn_ds_read_tr16_b64_v4i16((LAS s16x4*)(base + img_off(row + 4, col)));
    bf16x8 r; r[0] = lo[0]; r[1] = lo[1]; r[2] = lo[2]; r[3] = lo[3]; r[4] = hi[0]; r[5] = hi[1]; r[6] = hi[2]; r[7] = hi[3];
    return r;
}
template <bool SCALE>
__device__ __forceinline__ void load_tile(LAS unsigned char* dst, const bf16_t* src, size_t ld, int nvalid, float lg, int tid) {
#pragma unroll
    for (int i = 0; i < 8; ++i) {
        const int idx = i * 512 + tid, row = idx >> 5, ch = idx & 31;
        u32x4 v = (u32x4){0u, 0u, 0u, 0u};
        if (row < nvalid) {
            v = *(const u32x4*)(src + (size_t)row * ld + ch * 8);
            if (SCALE) { const float f = exp2f(lg * (float)(nvalid - 1 - row));
                v.x = pk_bf16(bf_lo(v.x) * f, bf_hi(v.x) * f); v.y = pk_bf16(bf_lo(v.y) * f, bf_hi(v.y) * f);
                v.z = pk_bf16(bf_lo(v.z) * f, bf_hi(v.z) * f); v.w = pk_bf16(bf_lo(v.w) * f, bf_hi(v.w) * f); }
        }
        *(LAS u32x4*)(dst + img_off(row, ch * 8)) = v;
    }
}

__device__ __forceinline__ void tr_tile(LAS float* tile, const float* src, int N, bf16_t* dst, int Kd, int k0, int n0, const float* scale, const float* nscale, int tid) {
    constexpr int P = 257;
    f32x4 v[8];
#pragma unroll
    for (int i = 0; i < 8; ++i) { const int idx4 = i * 512 + tid, r = idx4 >> 6, c4 = (idx4 & 63) * 4;
        v[i] = __builtin_nontemporal_load((const f32x4*)(src + (size_t)(k0 + r) * N + n0 + c4)); }
#pragma unroll
    for (int i = 0; i < 8; ++i) { const int idx4 = i * 512 + tid, r = idx4 >> 6, c4 = (idx4 & 63) * 4;
        f32x4 w = v[i]; if (scale) w *= scale[k0 + r]; if (nscale) w *= *(const f32x4*)(nscale + n0 + c4);
        tile[r * P + c4] = w[0]; tile[r * P + c4 + 1] = w[1]; tile[r * P + c4 + 2] = w[2]; tile[r * P + c4 + 3] = w[3]; }
    __syncthreads();
#pragma unroll
    for (int i = 0; i < 8; ++i) { const int idx = i * 512 + tid, n = idx >> 4, k4 = (idx & 15) * 4;
        u32x2 w; w.x = pk_bf16(tile[(k4) * P + n], tile[(k4 + 1) * P + n]); w.y = pk_bf16(tile[(k4 + 2) * P + n], tile[(k4 + 3) * P + n]);
        *(u32x2*)(dst + (size_t)(n0 + n) * Kd + k0 + k4) = w; }
    __syncthreads();
}

__device__ __forceinline__ void conv_item(const Params& p, int l, int t, LAS unsigned char* lds, int tid) {
    LAS float* tile = (LAS float*)lds;
    if (t < 2048) { const int kt = t >> 6, nt_ = t & 63;
        tr_tile(tile, p.w_in + (size_t)l * D * NIN, NIN, (bf16_t*)(pws(p) + OFF_WIN + l * SZ_WIN), D, kt * 64, nt_ * 256, p.norm_gain + l * D, nullptr, tid);
    } else if (t < 2112) { const int g = (t - 2048) >> 4, tt = (t - 2048) & 15, kt = tt >> 1, nt_ = tt & 1;
        tr_tile(tile, p.pool_w + ((size_t)l * 4 + g) * 512 * 512, 512, (bf16_t*)(pws(p) + OFF_WPOOL + l * SZ_WPOOL) + (size_t)g * 512 * 512, 512, kt * 64, nt_ * 256, nullptr, p.pool_scale + (size_t)l * D + g * 512, tid);
    } else { const int j = (t - 2112) >> 8, tt = (t - 2112) & 255, kt = tt >> 3, nt_ = tt & 7;
        const float* src = (j == 0 ? p.proj_pool : j == 1 ? p.proj_ret : p.w_out) + (size_t)l * D * D;
        bf16_t* dst = j == 2 ? (bf16_t*)(pws(p) + OFF_WOUT + l * SZ_WOUT) : (bf16_t*)(pws(p) + OFF_WPR + l * SZ_WPR) + (size_t)j * D * D;
        tr_tile(tile, src, D, dst, D, kt * 64, nt_ * 256, nullptr, nullptr, tid);
    }
}

__device__ void phase0(const Params& p, LAS unsigned char* lds, const int tid_in, const int bid) {
    const int tid = launder(tid_in);
    const int wid = tid >> 6, lane = tid & 63;
    constexpr int NT_L = 2880, NROWI = MPAD / 8;
    if (bid == 0 && tid < 128) {
        const float invf = powf(10000.0f, -(float)tid / 128.0f);
        const double c = (double)invf * 0.15915494309189535;
        const float hi = (float)c, lo = (float)(c - (double)hi);
        float* cf = (float*)(pws(p) + OFF_CS) + tid * 2; cf[0] = hi; cf[1] = lo;
    }
    for (int it = bid; it < NT_L + NROWI; it += gridDim.x) {
        if (it < NT_L) {
            conv_item(p, 0, it, lds, tid);
        } else {
            const int row = (it - NT_L) * 8 + wid;
            float* xf = (float*)(pws(p) + OFF_XF) + (size_t)row * D; bf16_t* xb = (bf16_t*)(pws(p) + OFF_XB) + (size_t)row * D; float* rsq = (float*)(pws(p) + OFF_RSQ);
            const float* src = nullptr;
            if (row < MS) src = p.x_sample + (size_t)row * D;
            else if (row < MR) { const int pr = row - MS, b = pr / LP, pp = pr % LP; src = pp < 16 ? p.meta + (size_t)pp * D : p.x_prompt + ((size_t)b * 2048 + pp - 16) * D; }
            f32x4 v[8];
#pragma unroll
            for (int i = 0; i < 8; ++i) { v[i] = (f32x4){0.f, 0.f, 0.f, 0.f}; if (src) v[i] = *(const f32x4*)(src + i * 256 + lane * 4); }
            float ss = 0.f;
#pragma unroll
            for (int i = 0; i < 8; ++i) { const int c = i * 256 + lane * 4;
                *(f32x4*)(xf + c) = v[i]; u32x2 w; w.x = pk_bf16(v[i][0], v[i][1]); w.y = pk_bf16(v[i][2], v[i][3]); *(u32x2*)(xb + c) = w;
                ss += v[i][0] * v[i][0] + v[i][1] * v[i][1] + v[i][2] * v[i][2] + v[i][3] * v[i][3]; }
            ss = wave_sum(ss);
            if (lane == 0) { rsq[row] = ss; rsq[MPAD + row] = 0.f; }
        }
    }
}

__device__ void sample_ret_unit(const Params& p, int l, int unit, LAS unsigned char* lds, const int tid_in) {
    const int tid = launder(tid_in);
    const int wid = tid >> 6, lane = tid & 63;
    const int b = unit >> 3, h = unit & 7, r0 = b * 8;
    const float lg = lg2gamma(h);
    LAS float* sq = (LAS float*)lds; LAS float* sk = sq + 2048; LAS float* sv = sk + 2048; LAS float* sqT = sv + 2048; LAS float* skdT = sqT + 2048; LAS float* sc = skdT + 2048; LAS float* red = (LAS float*)(lds + 49152);
    const bf16_t* zb = (const bf16_t*)(pws(p) + OFF_ZB);
    { const int i = tid >> 6, d = (tid & 63) * 4; const bf16_t* zr = zb + (size_t)(r0 + i) * ZW + h * 256 + d;
        const u32x2 a = *(const u32x2*)(zr + ZC_Q), kk = *(const u32x2*)(zr + ZC_K), vv = *(const u32x2*)(zr + ZC_V);
        const float qf[4] = {bf_lo(a.x), bf_hi(a.x), bf_lo(a.y), bf_hi(a.y)}, kf[4] = {bf_lo(kk.x), bf_hi(kk.x), bf_lo(kk.y), bf_hi(kk.y)};
        const float dk = exp2f(lg * (float)(7 - i));
        *(LAS f32x4*)(sq + i * 256 + d) = (f32x4){qf[0], qf[1], qf[2], qf[3]};
        *(LAS f32x4*)(sk + i * 256 + d) = (f32x4){kf[0], kf[1], kf[2], kf[3]};
        *(LAS f32x4*)(sv + i * 256 + d) = (f32x4){bf_lo(vv.x), bf_hi(vv.x), bf_lo(vv.y), bf_hi(vv.y)};
#pragma unroll
        for (int j = 0; j < 4; ++j) { sqT[(d + j) * 8 + i] = qf[j]; skdT[(d + j) * 8 + i] = kf[j] * dk; } }
    __syncthreads();
    { const int i = wid; const f32x4 qv = *(const LAS f32x4*)(sq + i * 256 + lane * 4);
        for (int j = 0; j < 8; ++j) { const f32x4 kv = *(const LAS f32x4*)(sk + j * 256 + lane * 4);
            float s = wave_sum(qv[0] * kv[0] + qv[1] * kv[1] + qv[2] * kv[2] + qv[3] * kv[3]);
            if (lane == 0) sc[i * 8 + j] = j <= i ? s * exp2f(lg * (float)(i - j)) : 0.f; } }
    const int e4 = lane * 4;
    f32x4 vv[8], oacc[8];
#pragma unroll
    for (int j = 0; j < 8; ++j) { vv[j] = *(const LAS f32x4*)(sv + j * 256 + e4); oacc[j] = (f32x4){0.f, 0.f, 0.f, 0.f}; }
    const float g8 = exp2f(lg * 8.0f);
    const size_t sbase = (((size_t)l * 128 + b) * 8 + h) * 65536;
    const float* Sin = p.state_ret + sbase; float* Sout = pout(p) + O_RS + sbase;
    f32x4 S4[8], N4[8];
#pragma unroll
    for (int u = 0; u < 8; ++u) S4[u] = __builtin_nontemporal_load((const f32x4*)(Sin + (size_t)(wid * 32 + u) * 256 + e4));
#pragma unroll
    for (int dd = 0; dd < 32; dd += 8) {
        const int d0 = launder(wid * 32 + dd);
        const int dn = dd + 8 < 32 ? d0 + 8 : d0;
#pragma unroll
        for (int u = 0; u < 8; ++u) N4[u] = __builtin_nontemporal_load((const f32x4*)(Sin + (size_t)(dn + u) * 256 + e4));
        asm volatile("" ::: "memory");
#pragma unroll
        for (int u = 0; u < 8; ++u) {
            const f32x4 q0 = *(const LAS f32x4*)(sqT + (d0 + u) * 8), q1 = *(const LAS f32x4*)(sqT + (d0 + u) * 8 + 4);
            const f32x4 k0 = *(const LAS f32x4*)(skdT + (d0 + u) * 8), k1 = *(const LAS f32x4*)(skdT + (d0 + u) * 8 + 4);
            f32x4 sn = S4[u] * g8;
            sn += vv[0] * k0[0]; sn += vv[1] * k0[1]; sn += vv[2] * k0[2]; sn += vv[3] * k0[3];
            sn += vv[4] * k1[0]; sn += vv[5] * k1[1]; sn += vv[6] * k1[2]; sn += vv[7] * k1[3];
            __builtin_nontemporal_store(sn, (f32x4*)(Sout + (size_t)(d0 + u) * 256 + e4));
            oacc[0] += S4[u] * q0[0]; oacc[1] += S4[u] * q0[1]; oacc[2] += S4[u] * q0[2]; oacc[3] += S4[u] * q0[3];
            oacc[4] += S4[u] * q1[0]; oacc[5] += S4[u] * q1[1]; oacc[6] += S4[u] * q1[2]; oacc[7] += S4[u] * q1[3];
        }
        asm volatile("" ::: "memory");
#pragma unroll
        for (int u = 0; u < 8; ++u) S4[u] = N4[u];
    }
#pragma unroll
    for (int i = 0; i < 8; ++i) *(LAS f32x4*)(red + (wid * 8 + i) * 256 + e4) = oacc[i];
    __syncthreads();
    { const int i = wid;
        f32x4 o = (f32x4){0.f, 0.f, 0.f, 0.f};
#pragma unroll
        for (int w = 0; w < 8; ++w) o += *(const LAS f32x4*)(red + (w * 8 + i) * 256 + e4);
        o *= exp2f(lg * (float)(i + 1));
        for (int j = 0; j <= i; ++j) o += *(const LAS f32x4*)(sv + j * 256 + e4) * sc[i * 8 + j];
        const float mu = wave_sum(o[0] + o[1] + o[2] + o[3]) * (1.0f / 256.0f);
        o -= mu;
        const float var = wave_sum(o[0] * o[0] + o[1] * o[1] + o[2] * o[2] + o[3] * o[3]) * (1.0f / 256.0f);
        const float rs = rsqrtf(var + EPS);
        const f32x4 gn = *(const f32x4*)(p.ret_gn + (size_t)l * D + h * 256 + e4);
        const u32x2 rg = *(const u32x2*)(zb + (size_t)(r0 + i) * ZW + ZC_RG + h * 256 + e4);
        u32x2 w; w.x = pk_bf16(o[0] * rs * gn[0] * bf_lo(rg.x), o[1] * rs * gn[1] * bf_hi(rg.x)); w.y = pk_bf16(o[2] * rs * gn[2] * bf_lo(rg.y), o[3] * rs * gn[3] * bf_hi(rg.y));
        *(u32x2*)((bf16_t*)(pws(p) + OFF_AIN) + ((size_t)MPAD + r0 + i) * D + h * 256 + e4) = w; }
    __syncthreads();
}

__device__ __forceinline__ void chunk_geom(int unit, int& b, int& h, int& c, int& n, int& R0, int& slot) {
    int bh; if (unit < 32) { bh = unit; c = 0; } else { bh = (unit - 32) >> 4; c = 1 + ((unit - 32) & 15); }
    b = bh >> 3; h = bh & 7;
    n = c ? 128 : 16; R0 = MS + b * LP + (c ? 16 + 128 * (c - 1) : 0); slot = bh * 17 + c;
}

__device__ void kv_unit(const Params& p, int unit, LAS unsigned char* lds, const int tid_in) {
    const int tid = launder(tid_in); const int wid = __builtin_amdgcn_readfirstlane(tid >> 6);
    int b, h, c, n, R0, slot; chunk_geom(unit, b, h, c, n, R0, slot);
    const float lg = lg2gamma(h);
    const bf16_t* zb = (const bf16_t*)(pws(p) + OFF_ZB) + (size_t)R0 * ZW + h * 256;
    LAS unsigned char* regA = lds; LAS unsigned char* regB = lds + 65536;
    load_tile<true>(regA, zb + ZC_K, ZW, n, lg, tid);
    load_tile<false>(regB, zb + ZC_V, ZW, n, 0.f, tid);
    __syncthreads();
    const int db = (wid >> 1) * 64, ebase = (wid & 1) * 128;
    float* kv = (float*)(pws(p) + OFF_KV) + (size_t)slot * 65536;
    const int nks = n >> 5 ? n >> 5 : 1;
#pragma unroll 1
    for (int pass = 0; pass < 4; ++pass) {
        const int eb = ebase + pass * 32;
        const int lane = launder(tid) & 63;
        f32x4 acc[4][2];
#pragma unroll
        for (int i = 0; i < 4; ++i)
#pragma unroll
            for (int j = 0; j < 2; ++j) acc[i][j] = (f32x4){0.f, 0.f, 0.f, 0.f};
#pragma unroll 1
        for (int ks = 0; ks < nks; ++ks) {
            bf16x8 a[4], bb[2];
#pragma unroll
            for (int i = 0; i < 4; ++i) a[i] = frag_tr(regA, ks * 32, db + i * 16, lane);
#pragma unroll
            for (int j = 0; j < 2; ++j) bb[j] = frag_tr(regB, ks * 32, eb + j * 16, lane);
#pragma unroll
            for (int i = 0; i < 4; ++i)
#pragma unroll
                for (int j = 0; j < 2; ++j) acc[i][j] = __builtin_amdgcn_mfma_f32_16x16x32_bf16(a[i], bb[j], acc[i][j], 0, 0, 0);
        }
        float* kp = kv + (size_t)(db + 4 * (lane >> 4)) * 256 + eb + (lane & 15);
#pragma unroll
        for (int i = 0; i < 4; ++i)
#pragma unroll
            for (int jj = 0; jj < 4; ++jj)
#pragma unroll
                for (int j = 0; j < 2; ++j) kp[(i * 16 + jj) * 256 + j * 16] = acc[i][j][jj];
    }
    __syncthreads();
}

__device__ void pool_item(const Params& p, int l, int item, const int tid_in) {
    const int tid = launder(tid_in);
    const int col = tid * 4, g = tid >> 7, w = 2 << g;
    const float* u = (const float*)(pws(p) + OFF_U);
    bf16_t* pooled = (bf16_t*)(pws(p) + OFF_POOLED);
    f32x4 p_self = (f32x4){0.f, 0.f, 0.f, 0.f}, p_res = p_self, p_hist = p_self;
#pragma unroll 1
    for (int rr = 0; rr <= 16; ++rr) {
        const int row = item * 16 + rr;
        f32x4 self = (f32x4){0.f, 0.f, 0.f, 0.f}, sum = self, hcopy = self; float cnt = 1.f;
        if (rr < 16) {
            self = *(const f32x4*)(u + (size_t)row * D + col); sum = self;
            if (row < MS) {
                const int b = row >> 3, t = row & 7;
                const float* hist = p.state_pool + ((size_t)l * 128 + b) * 15 * D + col;
                for (int i = 1; i < w; ++i) { const int tt = t - i;
                    sum += tt >= 0 ? *(const f32x4*)(u + (size_t)(row - i) * D + col) : *(const f32x4*)(hist + (size_t)(15 + tt) * D); }
                cnt = (float)w;
                if (t < 7) hcopy = *(const f32x4*)(hist + (size_t)(8 + t) * D);
            } else {
                const int pp = (row - MS) % LP;
                for (int i = 1; i < w; ++i) if (pp - i >= 0) sum += *(const f32x4*)(u + (size_t)(row - i) * D + col);
                cnt = (float)(w < pp + 1 ? w : pp + 1);
            }
        }
        asm volatile("" ::: "memory");
        if (rr > 0) {
            const int prow = row - 1;
            u32x2 o; o.x = pk_bf16(p_res[0], p_res[1]); o.y = pk_bf16(p_res[2], p_res[3]);
            *(u32x2*)(pooled + (size_t)prow * D + col) = o;
            if (prow < MS) {
                const int b = prow >> 3, t = prow & 7;
                float* np = pout(p) + O_PS + ((size_t)l * 128 + b) * 15 * D + col;
                *(f32x4*)(np + (size_t)(7 + t) * D) = p_self;
                if (t < 7) *(f32x4*)(np + (size_t)t * D) = p_hist;
            } else {
                const int pr = prow - MS, b = pr / LP, pp = pr % LP;
                if (pp >= 2049) *(f32x4*)(pout(p) + O_PP + (((size_t)l * 4 + b) * 15 + (pp - 2049)) * D + col) = p_self;
            }
        }
        asm volatile("" ::: "memory");
        p_res = sum * (1.0f / cnt) - self; p_self = self; p_hist = hcopy;
    }
}

__device__ void scan_item2(const Params& p, int l, int itemA, int itemB, const int tid_in) {
    const int tid = launder(tid_in);
    const int bhA = itemA >> 5, eA = ((itemA & 31) * 512 + tid) * 4, bhB = itemB >> 5, eB = ((itemB & 31) * 512 + tid) * 4;
    const float dA = exp2f(lg2gamma(bhA & 7) * 128.0f), dB = exp2f(lg2gamma(bhB & 7) * 128.0f);
    const float* kvA = (const float*)(pws(p) + OFF_KV) + (size_t)bhA * 17 * 65536 + eA;
    const float* kvB = (const float*)(pws(p) + OFF_KV) + (size_t)bhB * 17 * 65536 + eB;
    bf16_t* sbA = (bf16_t*)(pws(p) + OFF_SB) + (size_t)bhA * 17 * 65536 + eA;
    bf16_t* sbB = (bf16_t*)(pws(p) + OFF_SB) + (size_t)bhB * 17 * 65536 + eB;
    f32x4 ka[17], kb[17];
#pragma unroll
    for (int c = 0; c < 17; ++c) { ka[c] = __builtin_nontemporal_load((const f32x4*)(kvA + (size_t)c * 65536)); kb[c] = __builtin_nontemporal_load((const f32x4*)(kvB + (size_t)c * 65536)); }
    asm volatile("" ::: "memory");
    f32x4 SA = ka[0], SB = kb[0];
#pragma unroll
    for (int c = 1; c < 17; ++c) {
        u32x2 w; w.x = pk_bf16(SA[0], SA[1]); w.y = pk_bf16(SA[2], SA[3]);
        *(u32x2*)(sbA + (size_t)c * 65536) = w;
        w.x = pk_bf16(SB[0], SB[1]); w.y = pk_bf16(SB[2], SB[3]);
        *(u32x2*)(sbB + (size_t)c * 65536) = w;
        SA = SA * dA + ka[c]; SB = SB * dB + kb[c];
    }
    *(f32x4*)(pout(p) + O_RP + ((size_t)l * 32 + bhA) * 65536 + eA) = SA;
    *(f32x4*)(pout(p) + O_RP + ((size_t)l * 32 + bhB) * 65536 + eB) = SB;
}

__device__ void ret_out_unit(const Params& p, int l, int unit, LAS unsigned char* lds, const int tid_in) {
    const int tid = launder(tid_in); const int wid = __builtin_amdgcn_readfirstlane(tid >> 6);
    int b, h, c, n, R0, slot; chunk_geom(unit, b, h, c, n, R0, slot);
    const float lg = lg2gamma(h);
    const bf16_t* zb = (const bf16_t*)(pws(p) + OFF_ZB) + (size_t)R0 * ZW + h * 256;
    LAS unsigned char* regA = lds; LAS unsigned char* regB = lds + 65536;
    load_tile<false>(regA, zb + ZC_Q, ZW, n, 0.f, tid);
    load_tile<false>(regB, zb + ZC_K, ZW, n, 0.f, tid);
    __syncthreads();
    const int jb = (wid & 3) * 32, ib = (wid >> 2) * 64;
    u32x2 pk[2][4];
    {
        const int lane = launder(tid) & 63, g = lane >> 4, lc = lane & 15;
        f32x4 sc[2][4];
#pragma unroll
        for (int i = 0; i < 2; ++i)
#pragma unroll
            for (int j = 0; j < 4; ++j) sc[i][j] = (f32x4){0.f, 0.f, 0.f, 0.f};
#pragma unroll 1
        for (int ks = 0; ks < 8; ++ks) {
            bf16x8 a[2], bq[4];
#pragma unroll
            for (int i = 0; i < 2; ++i) a[i] = frag_direct(regB, jb + i * 16, ks * 32, lane);
#pragma unroll
            for (int j = 0; j < 4; ++j) bq[j] = frag_direct(regA, ib + j * 16, ks * 32, lane);
#pragma unroll
            for (int i = 0; i < 2; ++i)
#pragma unroll
                for (int j = 0; j < 4; ++j) sc[i][j] = __builtin_amdgcn_mfma_f32_16x16x32_bf16(a[i], bq[j], sc[i][j], 0, 0, 0);
        }
#pragma unroll
        for (int i = 0; i < 2; ++i)
#pragma unroll
            for (int j = 0; j < 4; ++j) {
                const int ii = ib + j * 16 + lc; float v[4];
#pragma unroll
                for (int jj = 0; jj < 4; ++jj) { const int jx = jb + i * 16 + 4 * g + jj; v[jj] = jx <= ii ? sc[i][j][jj] * exp2f(lg * (float)(ii - jx)) : 0.f; }
                pk[i][j].x = pk_bf16(v[0], v[1]); pk[i][j].y = pk_bf16(v[2], v[3]);
            }
    }
    const int ib2 = (wid >> 1) * 32, eb = (wid & 1) * 128;
    f32x4 acc[2][8];
#pragma unroll
    for (int i = 0; i < 2; ++i)
#pragma unroll
        for (int j = 0; j < 8; ++j) acc[i][j] = (f32x4){0.f, 0.f, 0.f, 0.f};
    if (c > 0) {
        const int lane = launder(tid) & 63, g = lane >> 4;
        const bf16_t* sb = (const bf16_t*)(pws(p) + OFF_SB) + (size_t)slot * 65536;
#pragma unroll 1
        for (int half = 0; half < 2; ++half) {
            __syncthreads();
            load_tile<false>(regB, sb + (size_t)half * 128 * 256, 256, 128, 0.f, tid);
            __syncthreads();
#pragma unroll 1
            for (int ks = 0; ks < 4; ++ks) {
                bf16x8 a[2];
#pragma unroll
                for (int i = 0; i < 2; ++i) a[i] = frag_direct(regA, ib2 + i * 16, half * 128 + ks * 32, lane);
#pragma unroll
                for (int j = 0; j < 8; ++j) { const bf16x8 bs = frag_tr(regB, ks * 32, eb + j * 16, lane);
#pragma unroll
                    for (int i = 0; i < 2; ++i) acc[i][j] = __builtin_amdgcn_mfma_f32_16x16x32_bf16(a[i], bs, acc[i][j], 0, 0, 0); }
            }
        }
#pragma unroll
        for (int i = 0; i < 2; ++i)
#pragma unroll
            for (int jj = 0; jj < 4; ++jj) { const float f = exp2f(lg * (float)(ib2 + i * 16 + 4 * g + jj + 1));
#pragma unroll
                for (int j = 0; j < 8; ++j) acc[i][j][jj] *= f; }
    }
    __syncthreads();
    { const int lane = launder(tid) & 63, g = lane >> 4, lc = lane & 15;
#pragma unroll
    for (int i = 0; i < 2; ++i)
#pragma unroll
        for (int j = 0; j < 4; ++j) *(LAS u32x2*)(regA + img_off(ib + j * 16 + lc, jb + i * 16 + 4 * g)) = pk[i][j]; }
    load_tile<false>(regB, zb + ZC_V, ZW, n, 0.f, tid);
    __syncthreads();
    const int ksmax = (ib2 + 31) >> 5;
    { const int lane = launder(tid) & 63;
#pragma unroll 1
    for (int ks = 0; ks <= ksmax; ++ks) {
        bf16x8 a[2];
#pragma unroll
        for (int i = 0; i < 2; ++i) a[i] = frag_direct(regA, ib2 + i * 16, ks * 32, lane);
#pragma unroll
        for (int j = 0; j < 8; ++j) { const bf16x8 bs = frag_tr(regB, ks * 32, eb + j * 16, lane);
#pragma unroll
            for (int i = 0; i < 2; ++i) acc[i][j] = __builtin_amdgcn_mfma_f32_16x16x32_bf16(a[i], bs, acc[i][j], 0, 0, 0); }
    } }
    __syncthreads();
    LAS float* oL = (LAS float*)lds;
    { const int lane = launder(tid) & 63, g = lane >> 4, lc = lane & 15;
#pragma unroll
    for (int i = 0; i < 2; ++i)
#pragma unroll
        for (int j = 0; j < 8; ++j)
#pragma unroll
            for (int jj = 0; jj < 4; ++jj) oL[(ib2 + i * 16 + 4 * g + jj) * 260 + eb + j * 16 + lc] = acc[i][j][jj]; }
    __syncthreads();
    const int lane = launder(tid) & 63;
    const f32x4 gn = *(const f32x4*)(p.ret_gn + (size_t)l * D + h * 256 + lane * 4);
    u32x2 rgv[16];
#pragma unroll
    for (int rr = 0; rr < 16; ++rr) { const int i = wid * 16 + rr; rgv[rr] = (u32x2){0u, 0u};
        if (i < n) rgv[rr] = *(const u32x2*)(zb + (size_t)i * ZW + ZC_RG + lane * 4); }
    asm volatile("" ::: "memory");
#pragma unroll
    for (int rr = 0; rr < 16; ++rr) {
        const int i = wid * 16 + rr;
        if (i < n) {
            f32x4 o = *(const LAS f32x4*)(oL + i * 260 + lane * 4);
            const float mu = wave_sum(o[0] + o[1] + o[2] + o[3]) * (1.0f / 256.0f);
            o -= mu;
            const float var = wave_sum(o[0] * o[0] + o[1] * o[1] + o[2] * o[2] + o[3] * o[3]) * (1.0f / 256.0f);
            const float rs = rsqrtf(var + EPS);
            const u32x2 rg = rgv[rr];
            u32x2 w; w.x = pk_bf16(o[0] * rs * gn[0] * bf_lo(rg.x), o[1] * rs * gn[1] * bf_hi(rg.x)); w.y = pk_bf16(o[2] * rs * gn[2] * bf_lo(rg.y), o[3] * rs * gn[3] * bf_hi(rg.y));
            *(u32x2*)((bf16_t*)(pws(p) + OFF_AIN) + ((size_t)MPAD + R0 + i) * D + h * 256 + lane * 4) = w;
        }
    }
    __syncthreads();
}

__device__ __forceinline__ float* final_dst(const Params& p, int row) {
    if (row < MS) return pout(p) + O_YS + (size_t)row * D;
    const int pr = row - MS, b = pr / LP, pp = pr % LP;
    return pp < 16 ? nullptr : pout(p) + O_YP + ((size_t)b * 2048 + pp - 16) * D;
}
__device__ void final_item(const Params& p, int item, const int tid_in) {
    const int tid = launder(tid_in);
    const int wid = tid >> 6, lane = tid & 63, r0 = item * 16 + wid, r1 = r0 + 8;
    float* d0 = final_dst(p, r0); float* d1 = final_dst(p, r1);
    const float* x0 = (const float*)(pws(p) + OFF_XF) + (size_t)r0 * D; const float* x1 = x0 + (size_t)8 * D;
    f32x4 v0[8], v1[8]; float s0 = 0.f, s1 = 0.f;
#pragma unroll
    for (int i = 0; i < 8; ++i) { v0[i] = *(const f32x4*)(x0 + i * 256 + lane * 4); v1[i] = *(const f32x4*)(x1 + i * 256 + lane * 4); }
#pragma unroll
    for (int i = 0; i < 8; ++i) { s0 += v0[i][0] * v0[i][0] + v0[i][1] * v0[i][1] + v0[i][2] * v0[i][2] + v0[i][3] * v0[i][3];
        s1 += v1[i][0] * v1[i][0] + v1[i][1] * v1[i][1] + v1[i][2] * v1[i][2] + v1[i][3] * v1[i][3]; }
    const float rs0 = rsqrtf(wave_sum(s0) * (1.0f / 2048.0f) + EPS), rs1 = rsqrtf(wave_sum(s1) * (1.0f / 2048.0f) + EPS);
#pragma unroll
    for (int i = 0; i < 8; ++i) { const f32x4 gg = *(const f32x4*)(p.final_norm + i * 256 + lane * 4);
        if (d0) *(f32x4*)(d0 + i * 256 + lane * 4) = v0[i] * rs0 * gg;
        if (d1) *(f32x4*)(d1 + i * 256 + lane * 4) = v1[i] * rs1 * gg; }
}

#ifndef PH_MASK
#define PH_MASK 0xff
#endif
__device__ __forceinline__ void run_phase(const Params& p, int ph, LAS unsigned char* lds, const int tid, const int bid) {
    const int G = gridDim.x;
    if (ph == 0) { if (PH_MASK & 1) phase0(p, lds, tid, bid); return; }
    if (ph == 13) { if (PH_MASK & 128) for (int it = bid; it < MR / 16; it += G) final_item(p, it, tid); return; }
    const int l = (ph - 1) / 6, sub = (ph - 1) % 6;
    if (sub == 0) { if (PH_MASK & 2) {
        SchedPlain S; S.init(MPAD, NIN, G, bid); S.A = pws(p) + OFF_XB; S.Bt = pws(p) + OFF_WIN + l * SZ_WIN; S.tstepA = (size_t)256 * D * 2; S.tstepB = (size_t)256 * D * 2;
        EpiWin E; E.u = (float*)(pws(p) + OFF_U); E.zb = (bf16_t*)(pws(p) + OFF_ZB); E.rsq = (const float*)(pws(p) + OFF_RSQ) + (size_t)l * MPAD; E.cf = (const float*)(pws(p) + OFF_CS);
        gemm_phase(lds, S, E, D, D, D, tid); }
    } else if (sub == 1) { if (PH_MASK & 4)
        for (int it = bid; it < 1024 + 544 + 580; it += G) {
            if (it < 1024) sample_ret_unit(p, l, it, lds, tid);
            else if (it < 1568) kv_unit(p, it - 1024, lds, tid);
            else pool_item(p, l, it - 1568, tid);
        }
    } else if (sub == 2) { if (PH_MASK & 8) {
        for (int it = bid; it + G < 1024; it += 2 * G) scan_item2(p, l, it, it + G, tid); }
    } else if (sub == 3) { if (PH_MASK & 16) {
        SchedPool S; S.init(MPAD, D, G, (bid + 128) % G); S.A = pws(p) + OFF_POOLED; S.Bt = pws(p) + OFF_WPOOL + l * SZ_WPOOL;
        EpiPool E; E.ain = (bf16_t*)(pws(p) + OFF_AIN); E.zb = (const bf16_t*)(pws(p) + OFF_ZB);
        gemm_phase(lds, S, E, 512, D, 512, tid);
        for (int it = bid; it < 544; it += G) ret_out_unit(p, l, it, lds, launder(tid)); }
    } else if (sub == 4) { if (PH_MASK & 32) {
        SchedDual S; S.init(MPAD, D, G, bid); S.A = pws(p) + OFF_AIN; S.Bt = pws(p) + OFF_WPR + l * SZ_WPR;
        EpiDual E; E.merged = (bf16_t*)(pws(p) + OFF_MERGED); E.zb = (const bf16_t*)(pws(p) + OFF_ZB);
        { const int sidx = bid < 40 ? bid : (bid < 80 ? bid - 40 : 0); E.m1 = (float*)(pws(p) + OFF_M1) + ((size_t)l * 40 + sidx) * 65536; E.flag = (unsigned*)(pws(p) + OFF_BAR + 16384) + (l * 40 + sidx) * 64; }
        gemm_phase(lds, S, E, D, D, D, tid);
        if (l == 0 && bid >= 80) for (int it = bid - 80; it < 1440; it += G - 80) conv_item(p, 1, it, lds, launder(tid)); }
    } else { if (PH_MASK & 64) {
        SchedPlain S; S.init(MPAD, D, G, bid); S.A = pws(p) + OFF_MERGED; S.Bt = pws(p) + OFF_WOUT + l * SZ_WOUT; S.tstepA = (size_t)256 * D * 2; S.tstepB = (size_t)256 * D * 2;
        EpiOut E; E.xf = (float*)(pws(p) + OFF_XF); E.xb = (bf16_t*)(pws(p) + OFF_XB); E.rsq_next = l == 0 ? (float*)(pws(p) + OFF_RSQ) + MPAD : nullptr;
        gemm_phase(lds, S, E, D, D, D, tid);
        if (l == 0 && bid >= 40) for (int it = 1440 + bid - 40; it < 2880; it += G - 40) conv_item(p, 1, it, lds, launder(tid)); }
    }
}

#define XB_TMO      128
#define XB_XCNT(j)  (256  + 64 * (j))
#define XB_XSUB(j)  (1280 + 64 * (j))
#define XB_XGEN(j)  (2304 + 64 * (j))
#define XB_TOP      3328
#define XB_TOPGEN   3392
#define XCD_BAR_WORDS 3456
#define XB_SPIN_CAP (1u << 18)
__device__ __forceinline__ unsigned xb_ld(unsigned* p)              { return __hip_atomic_load(p, __ATOMIC_RELAXED, __HIP_MEMORY_SCOPE_AGENT); }
__device__ __forceinline__ unsigned xb_add(unsigned* p, unsigned v) { return __hip_atomic_fetch_add(p, v, __ATOMIC_RELAXED, __HIP_MEMORY_SCOPE_AGENT); }
__device__ __forceinline__ unsigned xb_xcc_id() { return (unsigned)__builtin_amdgcn_s_getreg((3 << 11) | 20) & 0xFu; }
#define XB_SPIN(cond, bar) do { unsigned _sp = 0; while (cond) { __builtin_amdgcn_s_sleep(1); \
    if ((++_sp & 255u) == 0u) { if (xb_ld(&(bar)[XB_TMO])) break; if (_sp > XB_SPIN_CAP) { atomicAdd(&(bar)[XB_TMO], 1u); break; } } } } while (0)
struct XcdBarrier { unsigned* bar; unsigned x; volatile LAS unsigned* st; };
__device__ __forceinline__ XcdBarrier xcd_barrier_post(unsigned* bar, volatile LAS unsigned* st) {
    XcdBarrier b; b.bar = bar; b.x = xb_xcc_id(); b.st = st;
    if (threadIdx.x == 0) (void)xb_add(&bar[XB_XCNT(b.x)], 1u);
    return b;
}
__device__ __forceinline__ void xcd_barrier_complete(unsigned* bar, unsigned x, unsigned& nloc, unsigned& nx) {
    const unsigned G = gridDim.x * gridDim.y * gridDim.z;
    unsigned sum, cnt, mine, sp = 0u;
    for (;;) {
        sum = 0u; cnt = 0u; mine = 0u;
#pragma unroll
        for (unsigned j = 0; j < 16; ++j) { const unsigned c = xb_ld(&bar[XB_XCNT(j)]); sum += c; cnt += (c > 0u) ? 1u : 0u; mine = (j == x) ? c : mine; }
        if (sum == G) break;
        __builtin_amdgcn_s_sleep(1);
        if ((++sp & 255u) == 0u) { if (xb_ld(&bar[XB_TMO])) break; if (sp > XB_SPIN_CAP) { atomicAdd(&bar[XB_TMO], 1u); break; } }
    }
    nloc = mine > 0u ? mine : 1u; nx = cnt > 0u ? cnt : 1u;
}
__device__ __forceinline__ void xcd_barrier(unsigned* bar_in, LAS unsigned char* lds_in) {
    XcdBarrier b; b.bar = bar_in; b.x = xb_xcc_id(); b.st = (volatile LAS unsigned*)(lds_in + LDS_ST_OFF);
    asm volatile("s_waitcnt vmcnt(0)" ::: "memory");
    __syncthreads();
    if (threadIdx.x == 0) {
        unsigned* bar = b.bar;
        __builtin_amdgcn_s_waitcnt(0);
        unsigned nloc = b.st[0], nx = b.st[1];
        if (nloc == 0u) { xcd_barrier_complete(bar, b.x, nloc, nx); b.st[0] = nloc; b.st[1] = nx; }
        const unsigned old = xb_add(&bar[XB_XSUB(b.x)], 1u);
        const unsigned gen = old / nloc;
        if (old + 1u == (gen + 1u) * nloc) {
            __builtin_amdgcn_fence(__ATOMIC_RELEASE, "agent");
            asm volatile("s_waitcnt vmcnt(0)" ::: "memory");
            const unsigned og = xb_add(&bar[XB_TOP], 1u);
            const unsigned tg = og / nx;
            if (og + 1u == (tg + 1u) * nx) xb_add(&bar[XB_TOPGEN], 1u);
            else XB_SPIN(xb_ld(&bar[XB_TOPGEN]) == tg, bar);
            __builtin_amdgcn_fence(__ATOMIC_ACQUIRE, "agent");
            xb_add(&bar[XB_XGEN(b.x)], 1u);
            asm volatile("s_waitcnt vmcnt(0)" ::: "memory");
        } else {
            XB_SPIN(xb_ld(&bar[XB_XGEN(b.x)]) == gen, bar);
            __builtin_amdgcn_fence(__ATOMIC_ACQUIRE, "agent");
            asm volatile("s_waitcnt vmcnt(0)" ::: "memory");
        }
    }
    __syncthreads();
}

extern __shared__ __attribute__((aligned(16))) unsigned char smem_dyn[];

#if MULTI
__global__ void __launch_bounds__(512, 2) phase_kernel(Params p, int ph) {
    int tid = threadIdx.x; asm volatile("" : "+v"(tid));
    int bid = blockIdx.x; asm volatile("" : "+s"(bid));
    run_phase(p, ph, (LAS unsigned char*)smem_dyn, tid, bid);
}
#else
__global__ void __launch_bounds__(512, 2) mega_kernel(Params p, unsigned* bar) {
    cg::grid_group grid = cg::this_grid();
    LAS unsigned char* lds = (LAS unsigned char*)smem_dyn;
#ifndef REPEAT_SUB
#define REPEAT_SUB -1
#endif
    volatile LAS unsigned* st = (volatile LAS unsigned*)(lds + LDS_ST_OFF);
    if (threadIdx.x == 0) { st[0] = 0u; st[1] = 0u; }
    __syncthreads();
    (void)xcd_barrier_post(bar, st);
    int ph = 0, rep = 0;
#pragma unroll 1
    while (ph < 14) {
        int tid = threadIdx.x; asm volatile("" : "+v"(tid));
        int bid = blockIdx.x; asm volatile("" : "+s"(bid)); bid = __builtin_amdgcn_readfirstlane(bid);
        run_phase(p, ph, lds, tid, bid);
        if (ph < 13) xcd_barrier(bar, lds);
        if (gridDim.y == 7u) grid.sync();
        const bool match = (REPEAT_SUB == 100) ? (ph == 0) : (ph >= 1 && ph <= 12 && ((ph - 1) % 6) == REPEAT_SUB);
        if (match && rep == 0) rep = 1; else { rep = 0; ++ph; }
    }
}
#endif

extern "C" void kernel_launch(void* const* d_in, const int* in_sizes, int n_in, void* d_out, int out_size, void* d_ws, size_t ws_size, hipStream_t stream) {
    Params p{};
    p.x_prompt = (const float*)d_in[0]; p.x_sample = (const float*)d_in[1]; p.state_pool = (const float*)d_in[2]; p.state_ret = (const float*)d_in[3];
    p.meta = (const float*)d_in[4]; p.norm_gain = (const float*)d_in[5]; p.w_in = (const float*)d_in[6]; p.pool_w = (const float*)d_in[7];
    p.pool_scale = (const float*)d_in[8]; p.ret_gn = (const float*)d_in[9]; p.proj_pool = (const float*)d_in[10]; p.proj_ret = (const float*)d_in[11];
    p.w_out = (const float*)d_in[12]; p.final_norm = (const float*)d_in[13];
    p.out = (float*)d_out; p.ws = (char*)d_ws;
    if (ws_size < WS_TOTAL) { fprintf(stderr, "workspace too small: %zu < %zu\n", ws_size, (size_t)WS_TOTAL); return; }
#if MULTI
    static bool attr_set = false;
    if (!attr_set) { hipFuncSetAttribute((const void*)phase_kernel, hipFuncAttributeMaxDynamicSharedMemorySize, LDS_BYTES); attr_set = true; }
    for (int ph = 0; ph < 14; ++ph) phase_kernel<<<dim3(256), dim3(512), LDS_BYTES, stream>>>(p, ph);
#else
    static int grid_blocks = 0;
    if (!grid_blocks) {
        hipFuncSetAttribute((const void*)mega_kernel, hipFuncAttributeMaxDynamicSharedMemorySize, LDS_BYTES);
        int dev = 0, cus = 0, per_cu = 0;
        hipGetDevice(&dev);
        hipDeviceGetAttribute(&cus, hipDeviceAttributeMultiprocessorCount, dev);
        hipOccupancyMaxActiveBlocksPerMultiprocessor(&per_cu, mega_kernel, 512, LDS_BYTES);
        if (per_cu > 1) per_cu = 1;
        grid_blocks = cus * per_cu;
    }
    (void)hipMemsetAsync((char*)d_ws + OFF_BAR, 0, 16384 + 32768, stream);
    unsigned* bar = (unsigned*)((char*)d_ws + OFF_BAR);
    void* args[] = {&p, &bar};
    hipError_t e = hipLaunchCooperativeKernel((void*)mega_kernel, dim3(grid_blocks), dim3(512), args, LDS_BYTES, stream);
    if (e != hipSuccess) fprintf(stderr, "cooperative launch failed: %s (grid %d)\n", hipGetErrorString(e), grid_blocks);
#endif
}
```

```cpp
#include <hip/hip_runtime.h>
#include <hip/hip_cooperative_groups.h>
#include <cstdio>
namespace cg = cooperative_groups;

#ifndef MULTI
#define MULTI 0
#endif

#define LAS __attribute__((address_space(3)))
typedef unsigned short bf16_t;
typedef short bf16x8 __attribute__((ext_vector_type(8)));
typedef short s16x4 __attribute__((ext_vector_type(4)));
typedef float f32x4 __attribute__((ext_vector_type(4)));
typedef unsigned u32x4 __attribute__((ext_vector_type(4)));
typedef unsigned u32x2 __attribute__((ext_vector_type(2)));

constexpr int D = 2048, NIN = 16384, ZW = 14336;
constexpr int MS = 1024, LP = 2064, MR = 9280, MPAD = 9472, NMT = 37;
constexpr int NPOS = 2072;
constexpr int LDS_BYTES = 147456;
constexpr float EPS = 1e-6f;
constexpr int ZC_PG = 0, ZC_Q = 2048, ZC_K = 4096, ZC_V = 6144, ZC_RG = 8192, ZC_GP = 10240, ZC_GR = 12288;
constexpr size_t SZ_WIN = (size_t)NIN * D * 2, SZ_WPOOL = (size_t)2048 * 512 * 2, SZ_WPR = (size_t)4096 * D * 2, SZ_WOUT = (size_t)D * D * 2;
constexpr size_t OFF_WIN = 0;
constexpr size_t OFF_WPOOL = OFF_WIN + 2 * SZ_WIN;
constexpr size_t OFF_WPR = OFF_WPOOL + 2 * SZ_WPOOL;
constexpr size_t OFF_WOUT = OFF_WPR + 2 * SZ_WPR;
constexpr size_t OFF_XF = OFF_WOUT + 2 * SZ_WOUT;
constexpr size_t OFF_XB = OFF_XF + (size_t)MPAD * D * 4;
constexpr size_t OFF_RSQ = OFF_XB + (size_t)MPAD * D * 2;
constexpr size_t OFF_U = OFF_RSQ + (size_t)MPAD * 32 * 4;
constexpr size_t OFF_ZB = OFF_U + (size_t)MPAD * D * 4;
constexpr size_t OFF_POOLED = OFF_ZB + (size_t)MPAD * ZW * 2;
constexpr size_t OFF_AIN = OFF_POOLED + (size_t)MPAD * D * 2;
constexpr size_t OFF_M1 = OFF_AIN + (size_t)2 * MPAD * D * 2;
constexpr size_t OFF_MERGED = OFF_M1 + (size_t)MPAD * D * 4;
constexpr size_t OFF_KV = OFF_MERGED + (size_t)MPAD * D * 2;
constexpr size_t OFF_SB = OFF_KV + (size_t)544 * 65536 * 4;
constexpr size_t OFF_CS = OFF_SB + (size_t)544 * 65536 * 2;
constexpr size_t OFF_BAR = OFF_CS + (size_t)NPOS * 128 * 8;
constexpr size_t WS_TOTAL = OFF_BAR + 16384 + 32768;
constexpr int LDS_ST_OFF = 147440;
constexpr size_t O_YP = 0, O_YS = 16777216, O_PP = O_YS + 2097152, O_RP = O_PP + 245760, O_PS = O_RP + 4194304, O_RS = O_PS + 7864320;

struct Params {
    const float *x_prompt, *x_sample, *state_pool, *state_ret, *meta, *norm_gain, *w_in, *pool_w, *pool_scale, *ret_gn, *proj_pool, *proj_ret, *w_out, *final_norm;
    float* out;
    char* ws;
};

__device__ __forceinline__ char* pws(const Params& p) { return p.ws; }
__device__ __forceinline__ float* pout(const Params& p) { return p.out; }
__device__ __forceinline__ unsigned pk_bf16(float lo, float hi) { unsigned r; asm volatile("v_cvt_pk_bf16_f32 %0, %1, %2" : "=v"(r) : "v"(lo), "v"(hi)); return r; }
__device__ __forceinline__ float bf_lo(unsigned u) { return __uint_as_float(u << 16); }
__device__ __forceinline__ float bf_hi(unsigned u) { return __uint_as_float(u & 0xffff0000u); }
__device__ __forceinline__ float dpp_f(float v, const int ctrl_sel) {
    const int x = __builtin_bit_cast(int, v); int r;
    if (ctrl_sel == 0) r = __builtin_amdgcn_update_dpp(0, x, 0xB1, 0xF, 0xF, true);
    else if (ctrl_sel == 1) r = __builtin_amdgcn_update_dpp(0, x, 0x4E, 0xF, 0xF, true);
    else if (ctrl_sel == 2) r = __builtin_amdgcn_update_dpp(0, x, 0x141, 0xF, 0xF, true);
    else r = __builtin_amdgcn_update_dpp(0, x, 0x140, 0xF, 0xF, true);
    return __builtin_bit_cast(float, r);
}
__device__ __forceinline__ float wave_sum(float v) {
    v += dpp_f(v, 0); v += dpp_f(v, 1); v += dpp_f(v, 2); v += dpp_f(v, 3);
    const int x = __builtin_bit_cast(int, v);
    const float a = __builtin_bit_cast(float, __builtin_amdgcn_readlane(x, 0)), b = __builtin_bit_cast(float, __builtin_amdgcn_readlane(x, 16));
    const float c = __builtin_bit_cast(float, __builtin_amdgcn_readlane(x, 32)), d = __builtin_bit_cast(float, __builtin_amdgcn_readlane(x, 48));
    return (a + b) + (c + d);
}
__device__ __forceinline__ int launder(int v) { asm volatile("" : "+v"(v)); return v; }
__device__ __forceinline__ float lg2gamma(int h) { return log1pf(-exp2f(-5.0f - (float)h)) * 1.4426950408889634f; }
__device__ __forceinline__ float sigmoidf_(float x) { return __builtin_amdgcn_rcpf(1.0f + __expf(-x)); }
__device__ __forceinline__ float siluf_(float x) { return x * sigmoidf_(x); }

constexpr int BM = 256, BK = 64, HALF = 128, HTB = HALF * BK * 2, NXCD = 8, WGM = 8;
__device__ __forceinline__ int lds_byte(int r, int c) { const int st = (r >> 4) * 2 + (c >> 5), rr = r & 15, cc = c & 31, ob = rr * 64 + cc * 2; return st * 1024 + (ob ^ (((ob >> 9) & 1) << 5)); }
__device__ __forceinline__ void stage_rc(int b, int& R, int& C) { const int st = b / 1024, sb = b % 1024, swz = sb ^ (((sb >> 9) & 1) << 5); R = (st >> 1) * 16 + swz / 64; C = (st & 1) * 32 + (swz % 64) / 2; }
__device__ __forceinline__ int perm32(int rho) { const int n = rho >> 4, i = rho & 15; return 8 * (i >> 2) + 4 * n + (i & 3); }

struct Unit { int pm, pn, mode; };
struct StaticOrder {
    int nM, nN, nwg, G, c;
    __device__ void init(int M, int N, int G_, int c_) { nM = M / BM; nN = N / BM; nwg = nM * nN; G = G_; c = c_; }
    __device__ bool next(int i, Unit& u) const {
        const long L = (long)i * G + c; if (L >= nwg) return false;
        int wgid = (int)L; { const int q = nwg / NXCD, r = nwg % NXCD, xcd = wgid % NXCD, off = wgid / NXCD; wgid = (xcd < r ? xcd * (q + 1) : r * (q + 1) + (xcd - r) * q) + off; }
        const int nig = WGM * nN, gid = wgid / nig, fm = gid * WGM, gsz = (nM - fm) < WGM ? (nM - fm) : WGM;
        u.pm = fm + ((wgid % nig) % gsz); u.pn = (wgid % nig) / gsz; u.mode = 0; return true;
    }
};

template <class Epi, class Sched>
__device__ __forceinline__ void gemm_phase(LAS unsigned char* lds, const Sched& S, const Epi& E, const int K, const int lda, const int ldb, const int tid) {
    const int wid = __builtin_amdgcn_readfirstlane(tid >> 6), lane = tid & 63, wr = wid >> 2, wc = wid & 3, fr = lane & 15, fq = lane >> 4;
    const int nt = K / BK;
    unsigned voffA[2], voffB[2];
#pragma unroll
    for (int i = 0; i < 2; ++i) { int R, C; stage_rc(tid * 16 + i * 8192, R, C); const int Rb = (R & ~31) + perm32(R & 31);
        voffA[i] = (unsigned)(R * lda + C) * 2u; voffB[i] = (unsigned)(Rb * ldb + C) * 2u; }
    const size_t kstep = (size_t)(BK * 2);
    const size_t hstepA = (size_t)HALF * lda * 2, hstepB = (size_t)HALF * ldb * 2;
    const unsigned ldsw = (unsigned)wid * 1024u;
    const int aoff = lds_byte(wr * 64 + fr, fq * 8), boff = lds_byte(wc * 32 + fr, fq * 8);
#define G_SA(b, h) (((b) * 2 + (h)) * HTB)
#define G_SB(b, h) ((4 + (b) * 2 + (h)) * HTB)
#define G_STAGE(bufoff, gbase, voff) do { _Pragma("unroll") for (int _i = 0; _i < 2; ++_i) \
        __builtin_amdgcn_global_load_lds((const unsigned*)((const char*)(gbase) + (voff)[_i]), (LAS unsigned*)(lds + (bufoff) + ldsw + _i * 8192), 16, 0, 0); } while (0)
#define G_LDA(dst, b, h) do { _Pragma("unroll") for (int m = 0; m < 4; ++m) _Pragma("unroll") for (int k = 0; k < 2; ++k) dst[m][k] = *(const LAS bf16x8*)(lds + G_SA(b, h) + aoff + m * 2048 + k * 1024); } while (0)
#define G_LDB(dst, b, h) do { _Pragma("unroll") for (int n = 0; n < 2; ++n) _Pragma("unroll") for (int k = 0; k < 2; ++k) dst[n][k] = *(const LAS bf16x8*)(lds + G_SB(b, h) + boff + n * 2048 + k * 1024); } while (0)
#define G_MMA(ai, bj, At, Bt) do { __builtin_amdgcn_s_setprio(1); _Pragma("unroll") for (int m = 0; m < 4; ++m) _Pragma("unroll") for (int n = 0; n < 2; ++n) _Pragma("unroll") for (int k = 0; k < 2; ++k) \
        acc[ai][bj][m][n] = __builtin_amdgcn_mfma_f32_16x16x32_bf16(Bt[n][k], At[m][k], acc[ai][bj][m][n], 0, 0, 0); __builtin_amdgcn_s_setprio(0); } while (0)
#define G_WAIT_V(n) asm volatile("s_waitcnt vmcnt(" #n ")" ::: "memory")
#define G_WAIT_L(n) asm volatile("s_waitcnt lgkmcnt(" #n ")" ::: "memory")
#define G_BAR __builtin_amdgcn_s_barrier()
#define G_SCHED __builtin_amdgcn_sched_barrier(0)
    Unit cur, nxt; int ui = 0;
    if (!S.next(0, cur)) return;
    f32x4 acc[2][2][4][2];
#pragma unroll
    for (int a = 0; a < 2; ++a)
#pragma unroll
        for (int b = 0; b < 2; ++b)
#pragma unroll
            for (int m = 0; m < 4; ++m)
#pragma unroll
                for (int n = 0; n < 2; ++n) acc[a][b][m][n] = (f32x4){0.f, 0.f, 0.f, 0.f};
    bf16x8 At[4][2], B0[2][2], B1[2][2];
    const char* cA; const char* cB; S.ptrs(cur, cA, cB);
    G_STAGE(G_SB(0, 0), cB, voffB); G_STAGE(G_SA(0, 0), cA, voffA); G_STAGE(G_SB(0, 1), cB + hstepB, voffB); G_STAGE(G_SA(0, 1), cA + hstepA, voffA);
    if (wr == 1) G_BAR;
    G_WAIT_V(4); G_BAR;
    G_STAGE(G_SB(1, 0), cB + kstep, voffB); G_STAGE(G_SA(1, 0), cA + kstep, voffA); G_STAGE(G_SB(1, 1), cB + hstepB + kstep, voffB);
    G_WAIT_V(6); G_BAR;
    for (;;) {
        const bool has_next = S.next(ui + 1, nxt);
        const char* nA = cA; const char* nB = cB; if (has_next) S.ptrs(nxt, nA, nB);
        for (int t = 0; t < nt; t += 2) {
            const bool last = (t == nt - 2);
            const char* a1 = cA + (size_t)(t + 1) * kstep;
            const char* a2 = last ? nA : cA + (size_t)(t + 2) * kstep; const char* b2 = last ? nB : cB + (size_t)(t + 2) * kstep;
            const char* a3 = a2 + kstep; const char* b3 = b2 + kstep;
            G_LDB(B0, 0, 0); G_SCHED; G_LDA(At, 0, 0); G_STAGE(G_SA(1, 1), a1 + hstepA, voffA);
            G_WAIT_L(8); G_BAR; G_WAIT_L(0); G_MMA(0, 0, At, B0); G_BAR; G_SCHED;
            G_LDB(B1, 0, 1); G_STAGE(G_SB(0, 0), b2, voffB);
            G_BAR; G_WAIT_L(0); G_MMA(0, 1, At, B1); G_BAR;
            G_LDA(At, 0, 1); G_STAGE(G_SA(0, 0), a2, voffA);
            G_BAR; G_WAIT_L(0); G_MMA(1, 0, At, B0); G_BAR; G_SCHED;
            G_STAGE(G_SB(0, 1), b2 + hstepB, voffB);
            G_WAIT_V(6); G_BAR; G_MMA(1, 1, At, B1); G_BAR;
            G_LDB(B0, 1, 0); G_SCHED; G_LDA(At, 1, 0); G_STAGE(G_SA(0, 1), a2 + hstepA, voffA);
            G_WAIT_L(8); G_BAR; G_WAIT_L(0); G_MMA(0, 0, At, B0); G_BAR; G_SCHED;
            G_LDB(B1, 1, 1); G_STAGE(G_SB(1, 0), b3, voffB);
            G_BAR; G_WAIT_L(0); G_MMA(0, 1, At, B1); G_BAR;
            G_LDA(At, 1, 1); G_STAGE(G_SA(1, 0), a3, voffA);
            G_BAR; G_WAIT_L(0); G_MMA(1, 0, At, B0); G_BAR; G_SCHED;
            G_STAGE(G_SB(1, 1), b3 + hstepB, voffB);
            G_WAIT_V(6); G_BAR; G_MMA(1, 1, At, B1); G_BAR;
        }
        const bool keep = E(acc, cur, wr, wc, fr, fq);
        if (!has_next) break;
        if (!keep)
#pragma unroll
        for (int a = 0; a < 2; ++a)
#pragma unroll
            for (int b = 0; b < 2; ++b)
#pragma unroll
                for (int m = 0; m < 4; ++m)
#pragma unroll
                    for (int n = 0; n < 2; ++n) acc[a][b][m][n] = (f32x4){0.f, 0.f, 0.f, 0.f};
        cur = nxt; cA = nA; cB = nB; ++ui;
    }
    G_WAIT_V(0);
    if (wr == 0) G_BAR;
    G_BAR;
#undef G_SA
#undef G_SB
#undef G_STAGE
#undef G_LDA
#undef G_LDB
#undef G_MMA
#undef G_WAIT_V
#undef G_WAIT_L
#undef G_BAR
#undef G_SCHED
}

struct SchedPlain : StaticOrder {
    const char* A; const char* Bt; size_t tstepA, tstepB;
    __device__ __forceinline__ void ptrs(const Unit& u, const char*& a, const char*& b) const { a = A + (size_t)u.pm * tstepA; b = Bt + (size_t)u.pn * tstepB; }
};
struct SchedPool : StaticOrder {
    const char* A; const char* Bt;
    __device__ __forceinline__ void ptrs(const Unit& u, const char*& a, const char*& b) const {
        a = A + ((size_t)u.pm * 256 * D + (size_t)(u.pn >> 1) * 512) * 2; b = Bt + (size_t)u.pn * 256 * 512 * 2; }
};
struct SchedDual : StaticOrder {
    const char* A; const char* Bt;
    __device__ bool next(int i, Unit& u) const {
        if (i < 2) { if (!StaticOrder::next(0, u)) return false; u.mode = i; return true; }
        if (i == 2 && c < 80) { StaticOrder t = *this; t.c = c < 40 ? c : c - 40; if (!t.next(1, u)) return false; u.mode = c < 40 ? 2 : 3; return true; }
        return false;
    }
    __device__ __forceinline__ void ptrs(const Unit& u, const char*& a, const char*& b) const {
        a = A + (size_t)((u.mode & 1) * NMT + u.pm) * 256 * D * 2; b = Bt + (size_t)((u.mode & 1) * 8 + u.pn) * 256 * D * 2; }
};

struct EpiWin {
    float* u; bf16_t* zb; const float* rsq; const float* cf;
    template <int KIND>
    __device__ __forceinline__ void body(f32x4 (&acc)[2][2][4][2], const Unit& un, int wr, int wc, int fr, int fq) const {
        const int sec = un.pn >> 3, colt = (un.pn & 7) * 256, cw = wc * 32 + 8 * fq;
        const int rbase = un.pm * 256 + wr * 64 + fr;
        float rstd[8];
#pragma unroll
        for (int i = 0; i < 8; ++i) rstd[i] = rsq[rbase + (i >> 2) * 128 + (i & 3) * 16];
        f32x4 cfv[4];
        if (KIND == 2 || KIND == 3) {
#pragma unroll
            for (int t = 0; t < 4; ++t) cfv[t] = *(const f32x4*)(cf + (size_t)cw * 2 + t * 4);
        }
#pragma unroll
        for (int i = 0; i < 8; ++i) rstd[i] = rsqrtf(rstd[i] * (1.0f / 2048.0f) + EPS);
#pragma unroll
        for (int ai = 0; ai < 2; ++ai)
#pragma unroll
            for (int m = 0; m < 4; ++m) {
                const int r = rbase + ai * 128 + m * 16;
                const float rs = rstd[ai * 4 + m];
                f32x4 v[2][2];
#pragma unroll
                for (int bj = 0; bj < 2; ++bj)
#pragma unroll
                    for (int n = 0; n < 2; ++n) v[bj][n] = acc[ai][bj][m][n] * rs;
                if (KIND == 0) {
                    float* up = u + (size_t)r * D + colt + cw;
#pragma unroll
                    for (int bj = 0; bj < 2; ++bj)
#pragma unroll
                        for (int n = 0; n < 2; ++n) *(f32x4*)(up + bj * 128 + 4 * n) = v[bj][n];
                } else {
                    if (KIND == 2 || KIND == 3) {
                        const float pos = r < MS ? (float)(16384 + (r & 7)) : (float)((r - MS) % LP);
                        const float sc = KIND == 3 ? 0.0625f : 1.0f;
#pragma unroll
                        for (int n = 0; n < 2; ++n)
#pragma unroll
                            for (int j = 0; j < 4; ++j) {
                                const int t = 4 * n + j; const float chi = cfv[t >> 1][(t & 1) * 2], clo = cfv[t >> 1][(t & 1) * 2 + 1];
                                const float pp = pos * chi, ee = fmaf(pos, chi, -pp);
                                const float rev = (pp - rintf(pp)) + fmaf(pos, clo, ee);
                                const float cc = __builtin_amdgcn_cosf(rev) * sc, ss = __builtin_amdgcn_sinf(rev) * sc;
                                const float t1 = v[0][n][j], t2 = v[1][n][j];
                                v[0][n][j] = t1 * cc - t2 * ss; v[1][n][j] = t2 * cc + t1 * ss; }
                    } else if (KIND == 1) {
#pragma unroll
                        for (int bj = 0; bj < 2; ++bj)
#pragma unroll
                            for (int n = 0; n < 2; ++n)
#pragma unroll
                                for (int j = 0; j < 4; ++j) v[bj][n][j] = siluf_(v[bj][n][j]);
                    } else if (KIND == 5) {
#pragma unroll
                        for (int bj = 0; bj < 2; ++bj)
#pragma unroll
                            for (int n = 0; n < 2; ++n)
#pragma unroll
                                for (int j = 0; j < 4; ++j) v[bj][n][j] = sigmoidf_(v[bj][n][j]);
                    }
                    bf16_t* zp = zb + (size_t)r * ZW + (size_t)(sec - 1) * 2048 + colt + cw;
#pragma unroll
                    for (int bj = 0; bj < 2; ++bj) { u32x4 w; w.x = pk_bf16(v[bj][0][0], v[bj][0][1]); w.y = pk_bf16(v[bj][0][2], v[bj][0][3]); w.z = pk_bf16(v[bj][1][0], v[bj][1][1]); w.w = pk_bf16(v[bj][1][2], v[bj][1][3]);
                        *(u32x4*)(zp + bj * 128) = w; }
                }
            }
    }
    __device__ __forceinline__ bool operator()(f32x4 (&acc)[2][2][4][2], const Unit& un, int wr, int wc, int fr, int fq) const {
        const int sec = un.pn >> 3;
        if (sec == 0) body<0>(acc, un, wr, wc, fr, fq);
        else if (sec == 1 || sec == 5) body<1>(acc, un, wr, wc, fr, fq);
        else if (sec == 2) body<2>(acc, un, wr, wc, fr, fq);
        else if (sec == 3) body<3>(acc, un, wr, wc, fr, fq);
        else if (sec == 4) body<4>(acc, un, wr, wc, fr, fq);
        else body<5>(acc, un, wr, wc, fr, fq);
        return false;
    }
};

struct EpiPool {
    bf16_t* ain; const bf16_t* zb;
    __device__ __forceinline__ bool operator()(f32x4 (&acc)[2][2][4][2], const Unit& un, int wr, int wc, int fr, int fq) const {
        const int c0 = un.pn * 256 + wc * 32 + 8 * fq;
        const int rbase = un.pm * 256 + wr * 64 + fr;
        u32x4 g[2][4][2];
#pragma unroll
        for (int ai = 0; ai < 2; ++ai)
#pragma unroll
            for (int m = 0; m < 4; ++m)
#pragma unroll
                for (int bj = 0; bj < 2; ++bj) g[ai][m][bj] = *(const u32x4*)(zb + (size_t)(rbase + ai * 128 + m * 16) * ZW + ZC_PG + c0 + bj * 128);
#pragma unroll
        for (int ai = 0; ai < 2; ++ai)
#pragma unroll
            for (int m = 0; m < 4; ++m) {
                const int r = rbase + ai * 128 + m * 16;
#pragma unroll
                for (int bj = 0; bj < 2; ++bj) {
                    const u32x4 gg = g[ai][m][bj];
                    const f32x4 v0 = acc[ai][bj][m][0], v1 = acc[ai][bj][m][1];
                    u32x4 w;
                    w.x = pk_bf16(v0[0] * bf_lo(gg.x), v0[1] * bf_hi(gg.x)); w.y = pk_bf16(v0[2] * bf_lo(gg.y), v0[3] * bf_hi(gg.y));
                    w.z = pk_bf16(v1[0] * bf_lo(gg.z), v1[1] * bf_hi(gg.z)); w.w = pk_bf16(v1[2] * bf_lo(gg.w), v1[3] * bf_hi(gg.w));
                    *(u32x4*)(ain + (size_t)r * D + c0 + bj * 128) = w;
                }
            }
        return false;
    }
};

struct EpiDual {
    bf16_t* merged; const bf16_t* zb; float* m1; unsigned* flag;
    __device__ __forceinline__ bool operator()(f32x4 (&acc)[2][2][4][2], const Unit& un, int wr, int wc, int fr, int fq) const {
        const int mode = un.mode;
        const int c0 = un.pn * 256 + wc * 32 + 8 * fq;
        const int rbase = un.pm * 256 + wr * 64 + fr;
        float* m1w = m1 + (size_t)(wr * 4 + wc) * 128 * 64 + launder(fq * 16 + fr);
        if (!(mode & 1)) {
#pragma unroll
            for (int ai = 0; ai < 2; ++ai)
#pragma unroll
            for (int mh = 0; mh < 2; ++mh) {
                u32x4 gp[2][2], gr[2][2];
#pragma unroll
                for (int m = 0; m < 2; ++m)
#pragma unroll
                    for (int bj = 0; bj < 2; ++bj) { const bf16_t* zp = zb + (size_t)(rbase + ai * 128 + (mh * 2 + m) * 16) * ZW + c0 + bj * 128;
                        gp[m][bj] = *(const u32x4*)(zp + ZC_GP); gr[m][bj] = *(const u32x4*)(zp + ZC_GR); }
#pragma unroll
                for (int m = 0; m < 2; ++m)
#pragma unroll
                    for (int bj = 0; bj < 2; ++bj) {
                        const u32x4 a = gp[m][bj], b = gr[m][bj];
                        f32x4& v0 = acc[ai][bj][mh * 2 + m][0]; f32x4& v1 = acc[ai][bj][mh * 2 + m][1];
                        if (mode == 0) {
                            v0[0] *= bf_lo(a.x) * __builtin_amdgcn_rcpf(bf_lo(b.x)); v0[1] *= bf_hi(a.x) * __builtin_amdgcn_rcpf(bf_hi(b.x));
                            v0[2] *= bf_lo(a.y) * __builtin_amdgcn_rcpf(bf_lo(b.y)); v0[3] *= bf_hi(a.y) * __builtin_amdgcn_rcpf(bf_hi(b.y));
                            v1[0] *= bf_lo(a.z) * __builtin_amdgcn_rcpf(bf_lo(b.z)); v1[1] *= bf_hi(a.z) * __builtin_amdgcn_rcpf(bf_hi(b.z));
                            v1[2] *= bf_lo(a.w) * __builtin_amdgcn_rcpf(bf_lo(b.w)); v1[3] *= bf_hi(a.w) * __builtin_amdgcn_rcpf(bf_hi(b.w));
                        } else {
                            v0[0] *= bf_lo(a.x); v0[1] *= bf_hi(a.x); v0[2] *= bf_lo(a.y); v0[3] *= bf_hi(a.y);
                            v1[0] *= bf_lo(a.z); v1[1] *= bf_hi(a.z); v1[2] *= bf_lo(a.w); v1[3] *= bf_hi(a.w);
                        }
                    }
            }
            if (mode == 0) return true;
#pragma unroll
            for (int ai = 0; ai < 2; ++ai)
#pragma unroll
                for (int bj = 0; bj < 2; ++bj)
#pragma unroll
                    for (int m = 0; m < 4; ++m)
#pragma unroll
                        for (int n = 0; n < 2; ++n)
#pragma unroll
                            for (int e = 0; e < 4; ++e) __hip_atomic_store(m1w + (((((ai * 2 + bj) * 4 + m) * 2 + n) * 4 + e) * 64), acc[ai][bj][m][n][e], __ATOMIC_RELAXED, __HIP_MEMORY_SCOPE_AGENT);
            asm volatile("s_waitcnt vmcnt(0)" ::: "memory");
            __builtin_amdgcn_fence(__ATOMIC_RELEASE, "agent");
            asm volatile("s_waitcnt vmcnt(0)" ::: "memory");
            if (fr == 0 && fq == 0) __hip_atomic_fetch_add(flag, 1u, __ATOMIC_RELAXED, __HIP_MEMORY_SCOPE_AGENT);
            return false;
        }
        if (mode == 3) {
            unsigned sp = 0;
            while (__hip_atomic_load(flag, __ATOMIC_RELAXED, __HIP_MEMORY_SCOPE_AGENT) < 8u) { __builtin_amdgcn_s_sleep(2); if (++sp > (1u << 22)) break; }
            __builtin_amdgcn_fence(__ATOMIC_ACQUIRE, "agent");
            asm volatile("s_waitcnt vmcnt(0)" ::: "memory");
#pragma unroll
            for (int ai = 0; ai < 2; ++ai)
#pragma unroll
                for (int bj = 0; bj < 2; ++bj) {
                    u32x4 gr[4]; f32x4 mv[4][2];
#pragma unroll
                    for (int m = 0; m < 4; ++m) { gr[m] = *(const u32x4*)(zb + (size_t)(rbase + ai * 128 + m * 16) * ZW + ZC_GR + c0 + bj * 128);
#pragma unroll
                        for (int n = 0; n < 2; ++n)
#pragma unroll
                            for (int e = 0; e < 4; ++e) mv[m][n][e] = __hip_atomic_load(m1w + (((((ai * 2 + bj) * 4 + m) * 2 + n) * 4 + e) * 64), __ATOMIC_RELAXED, __HIP_MEMORY_SCOPE_AGENT); }
#pragma unroll
                    for (int m = 0; m < 4; ++m) {
                        const int r = rbase + ai * 128 + m * 16;
                        const u32x4 b = gr[m];
                        f32x4 v0 = acc[ai][bj][m][0], v1 = acc[ai][bj][m][1];
                        v0[0] *= bf_lo(b.x); v0[1] *= bf_hi(b.x); v0[2] *= bf_lo(b.y); v0[3] *= bf_hi(b.y);
                        v1[0] *= bf_lo(b.z); v1[1] *= bf_hi(b.z); v1[2] *= bf_lo(b.w); v1[3] *= bf_hi(b.w);
                        v0 += mv[m][0]; v1 += mv[m][1];
                        u32x4 w; w.x = pk_bf16(v0[0], v0[1]); w.y = pk_bf16(v0[2], v0[3]); w.z = pk_bf16(v1[0], v1[1]); w.w = pk_bf16(v1[2], v1[3]);
                        *(u32x4*)(merged + (size_t)r * D + c0 + bj * 128) = w;
                    }
                }
            return false;
        }
        u32x4 gr[2][4][2];
#pragma unroll
        for (int ai = 0; ai < 2; ++ai)
#pragma unroll
            for (int m = 0; m < 4; ++m)
#pragma unroll
                for (int bj = 0; bj < 2; ++bj) gr[ai][m][bj] = *(const u32x4*)(zb + (size_t)(rbase + ai * 128 + m * 16) * ZW + ZC_GR + c0 + bj * 128);
#pragma unroll
        for (int ai = 0; ai < 2; ++ai)
#pragma unroll
            for (int m = 0; m < 4; ++m) {
                const int r = rbase + ai * 128 + m * 16;
#pragma unroll
                for (int bj = 0; bj < 2; ++bj) {
                    const u32x4 b = gr[ai][m][bj];
                    const f32x4 v0 = acc[ai][bj][m][0], v1 = acc[ai][bj][m][1];
                    u32x4 w; w.x = pk_bf16(v0[0] * bf_lo(b.x), v0[1] * bf_hi(b.x)); w.y = pk_bf16(v0[2] * bf_lo(b.y), v0[3] * bf_hi(b.y));
                    w.z = pk_bf16(v1[0] * bf_lo(b.z), v1[1] * bf_hi(b.z)); w.w = pk_bf16(v1[2] * bf_lo(b.w), v1[3] * bf_hi(b.w));
                    *(u32x4*)(merged + (size_t)r * D + c0 + bj * 128) = w;
                }
            }
        return false;
    }
};

struct EpiOut {
    float* xf; bf16_t* xb; float* rsq_next;
    __device__ __forceinline__ bool operator()(f32x4 (&acc)[2][2][4][2], const Unit& un, int wr, int wc, int fr, int fq) const {
        const int c0 = un.pn * 256 + wc * 32 + 8 * fq;
        const int rbase = un.pm * 256 + wr * 64 + fr;
#pragma unroll
        for (int ai = 0; ai < 2; ++ai) {
            f32x4 xv[4][2][2];
#pragma unroll
            for (int m = 0; m < 4; ++m)
#pragma unroll
                for (int bj = 0; bj < 2; ++bj) { const float* xp = xf + (size_t)(rbase + ai * 128 + m * 16) * D + c0 + bj * 128;
                    xv[m][bj][0] = *(const f32x4*)xp; xv[m][bj][1] = *(const f32x4*)(xp + 4); }
#pragma unroll
            for (int m = 0; m < 4; ++m) {
                const int r = rbase + ai * 128 + m * 16;
                float ssq = 0.f;
#pragma unroll
                for (int bj = 0; bj < 2; ++bj) {
                    float* xp = xf + (size_t)r * D + c0 + bj * 128;
                    const f32x4 v0 = xv[m][bj][0] + acc[ai][bj][m][0], v1 = xv[m][bj][1] + acc[ai][bj][m][1];
                    *(f32x4*)xp = v0; *(f32x4*)(xp + 4) = v1;
                    u32x4 w; w.x = pk_bf16(v0[0], v0[1]); w.y = pk_bf16(v0[2], v0[3]); w.z = pk_bf16(v1[0], v1[1]); w.w = pk_bf16(v1[2], v1[3]);
                    *(u32x4*)(xb + (size_t)r * D + c0 + bj * 128) = w;
#pragma unroll
                    for (int j = 0; j < 4; ++j) ssq += v0[j] * v0[j] + v1[j] * v1[j];
                }
                if (rsq_next) atomicAdd(rsq_next + r, ssq);
            }
        }
        return false;
    }
};

__device__ __forceinline__ int swz(int row) { return ((row & 3) << 2) | ((row >> 2) & 3); }
__device__ __forceinline__ int img_off(int row, int col) {
    const int sub = col >> 7, cc = col & 127;
    return sub * 32768 + 256 * row + 16 * ((cc >> 3) ^ swz(row)) + (cc & 7) * 2;
}
__device__ __forceinline__ bf16x8 frag_direct(LAS unsigned char* base, int r0, int k0, int lane) {
    return *(const LAS bf16x8*)(base + img_off(r0 + (lane & 15), k0 + 8 * (lane >> 4)));
}
__device__ __forceinline__ bf16x8 frag_tr(LAS unsigned char* base, int k0, int c0, int lane) {
    const int g = lane >> 4, q = (lane >> 2) & 3, p = lane & 3;
    const int row = k0 + 8 * g + q, col = c0 + 4 * p;
    const s16x4 lo = __builtin_amdgcn_ds_read_tr16_b64_v4i16((LAS s16x4*)(base + img_off(row, col)));
    const s16x4 hi = __builtin_amdgcn_ds_read_tr16_b64_v4i16((LAS s16x4*)(base + img_off(row + 4, col)));
    bf16x8 r; r[0] = lo[0]; r[1] = lo[1]; r[2] = lo[2]; r[3] = lo[3]; r[4] = hi[0]; r[5] = hi[1]; r[6] = hi[2]; r[7] = hi[3];
    return r;
}
template <bool SCALE>
__device__ __forceinline__ void load_tile(LAS unsigned char* dst, const bf16_t* src, size_t ld, int nvalid, float lg, int tid) {
#pragma unroll
    for (int i = 0; i < 8; ++i) {
        const int idx = i * 512 + tid, row = idx >> 5, ch = idx & 31;
        u32x4 v = (u32x4){0u, 0u, 0u, 0u};
        if (row < nvalid) {
            v = *(const u32x4*)(src + (size_t)row * ld + ch * 8);
            if (SCALE) { const float f = exp2f(lg * (float)(nvalid - 1 - row));
                v.x = pk_bf16(bf_lo(v.x) * f, bf_hi(v.x) * f); v.y = pk_bf16(bf_lo(v.y) * f, bf_hi(v.y) * f);
                v.z = pk_bf16(bf_lo(v.z) * f, bf_hi(v.z) * f); v.w = pk_bf16(bf_lo(v.w) * f, bf_hi(v.w) * f); }
        }
        *(LAS u32x4*)(dst + img_off(row, ch * 8)) = v;
    }
}

__device__ __forceinline__ void tr_tile(LAS float* tile, const float* src, int N, bf16_t* dst, int Kd, int k0, int n0, const float* scale, const float* nscale, int tid) {
    constexpr int P = 257;
    f32x4 v[8];
#pragma unroll
    for (int i = 0; i < 8; ++i) { const int idx4 = i * 512 + tid, r = idx4 >> 6, c4 = (idx4 & 63) * 4;
        v[i] = __builtin_nontemporal_load((const f32x4*)(src + (size_t)(k0 + r) * N + n0 + c4)); }
#pragma unroll
    for (int i = 0; i < 8; ++i) { const int idx4 = i * 512 + tid, r = idx4 >> 6, c4 = (idx4 & 63) * 4;
        f32x4 w = v[i]; if (scale) w *= scale[k0 + r]; if (nscale) w *= *(const f32x4*)(nscale + n0 + c4);
        tile[r * P + c4] = w[0]; tile[r * P + c4 + 1] = w[1]; tile[r * P + c4 + 2] = w[2]; tile[r * P + c4 + 3] = w[3]; }
    __syncthreads();
#pragma unroll
    for (int i = 0; i < 8; ++i) { const int idx = i * 512 + tid, n = idx >> 4, k4 = (idx & 15) * 4;
        u32x2 w; w.x = pk_bf16(tile[(k4) * P + n], tile[(k4 + 1) * P + n]); w.y = pk_bf16(tile[(k4 + 2) * P + n], tile[(k4 + 3) * P + n]);
        *(u32x2*)(dst + (size_t)(n0 + n) * Kd + k0 + k4) = w; }
    __syncthreads();
}

__device__ __forceinline__ void conv_item(const Params& p, int l, int t, LAS unsigned char* lds, int tid) {
    LAS float* tile = (LAS float*)lds;
    if (t < 2048) { const int kt = t >> 6, nt_ = t & 63;
        tr_tile(tile, p.w_in + (size_t)l * D * NIN, NIN, (bf16_t*)(pws(p) + OFF_WIN + l * SZ_WIN), D, kt * 64, nt_ * 256, p.norm_gain + l * D, nullptr, tid);
    } else if (t < 2112) { const int g = (t - 2048) >> 4, tt = (t - 2048) & 15, kt = tt >> 1, nt_ = tt & 1;
        tr_tile(tile, p.pool_w + ((size_t)l * 4 + g) * 512 * 512, 512, (bf16_t*)(pws(p) + OFF_WPOOL + l * SZ_WPOOL) + (size_t)g * 512 * 512, 512, kt * 64, nt_ * 256, nullptr, p.pool_scale + (size_t)l * D + g * 512, tid);
    } else { const int j = (t - 2112) >> 8, tt = (t - 2112) & 255, kt = tt >> 3, nt_ = tt & 7;
        const float* src = (j == 0 ? p.proj_pool : j == 1 ? p.proj_ret : p.w_out) + (size_t)l * D * D;
        bf16_t* dst = j == 2 ? (bf16_t*)(pws(p) + OFF_WOUT + l * SZ_WOUT) : (bf16_t*)(pws(p) + OFF_WPR + l * SZ_WPR) + (size_t)j * D * D;
        tr_tile(tile, src, D, dst, D, kt * 64, nt_ * 256, nullptr, nullptr, tid);
    }
}

__device__ void phase0(const Params& p, LAS unsigned char* lds, const int tid_in, const int bid) {
    const int tid = launder(tid_in);
    const int wid = tid >> 6, lane = tid & 63;
    constexpr int NT_L = 2880, NROWI = MPAD / 8;
    if (bid == 0 && tid < 128) {
        const float invf = powf(10000.0f, -(float)tid / 128.0f);
        const double c = (double)invf * 0.15915494309189535;
        const float hi = (float)c, lo = (float)(c - (double)hi);
        float* cf = (float*)(pws(p) + OFF_CS) + tid * 2; cf[0] = hi; cf[1] = lo;
    }
    for (int it = bid; it < NT_L + NROWI; it += gridDim.x) {
        if (it < NT_L) {
            conv_item(p, 0, it, lds, tid);
        } else {
            const int row = (it - NT_L) * 8 + wid;
            float* xf = (float*)(pws(p) + OFF_XF) + (size_t)row * D; bf16_t* xb = (bf16_t*)(pws(p) + OFF_XB) + (size_t)row * D; float* rsq = (float*)(pws(p) + OFF_RSQ);
            const float* src = nullptr;
            if (row < MS) src = p.x_sample + (size_t)row * D;
            else if (row < MR) { const int pr = row - MS, b = pr / LP, pp = pr % LP; src = pp < 16 ? p.meta + (size_t)pp * D : p.x_prompt + ((size_t)b * 2048 + pp - 16) * D; }
            f32x4 v[8];
#pragma unroll
            for (int i = 0; i < 8; ++i) { v[i] = (f32x4){0.f, 0.f, 0.f, 0.f}; if (src) v[i] = *(const f32x4*)(src + i * 256 + lane * 4); }
            float ss = 0.f;
#pragma unroll
            for (int i = 0; i < 8; ++i) { const int c = i * 256 + lane * 4;
                *(f32x4*)(xf + c) = v[i]; u32x2 w; w.x = pk_bf16(v[i][0], v[i][1]); w.y = pk_bf16(v[i][2], v[i][3]); *(u32x2*)(xb + c) = w;
                ss += v[i][0] * v[i][0] + v[i][1] * v[i][1] + v[i][2] * v[i][2] + v[i][3] * v[i][3]; }
            ss = wave_sum(ss);
            if (lane == 0) { rsq[row] = ss; rsq[MPAD + row] = 0.f; }
        }
    }
}

__device__ void sample_ret_unit(const Params& p, int l, int unit, LAS unsigned char* lds, const int tid_in) {
    const int tid = launder(tid_in);
    const int wid = tid >> 6, lane = tid & 63;
    const int b = unit >> 3, h = unit & 7, r0 = b * 8;
    const float lg = lg2gamma(h);
    LAS float* sq = (LAS float*)lds; LAS float* sk = sq + 2048; LAS float* sv = sk + 2048; LAS float* sqT = sv + 2048; LAS float* skdT = sqT + 2048; LAS float* sc = skdT + 2048; LAS float* red = (LAS float*)(lds + 49152);
    const bf16_t* zb = (const bf16_t*)(pws(p) + OFF_ZB);
    { const int i = tid >> 6, d = (tid & 63) * 4; const bf16_t* zr = zb + (size_t)(r0 + i) * ZW + h * 256 + d;
        const u32x2 a = *(const u32x2*)(zr + ZC_Q), kk = *(const u32x2*)(zr + ZC_K), vv = *(const u32x2*)(zr + ZC_V);
        const float qf[4] = {bf_lo(a.x), bf_hi(a.x), bf_lo(a.y), bf_hi(a.y)}, kf[4] = {bf_lo(kk.x), bf_hi(kk.x), bf_lo(kk.y), bf_hi(kk.y)};
        const float dk = exp2f(lg * (float)(7 - i));
        *(LAS f32x4*)(sq + i * 256 + d) = (f32x4){qf[0], qf[1], qf[2], qf[3]};
        *(LAS f32x4*)(sk + i * 256 + d) = (f32x4){kf[0], kf[1], kf[2], kf[3]};
        *(LAS f32x4*)(sv + i * 256 + d) = (f32x4){bf_lo(vv.x), bf_hi(vv.x), bf_lo(vv.y), bf_hi(vv.y)};
#pragma unroll
        for (int j = 0; j < 4; ++j) { sqT[(d + j) * 8 + i] = qf[j]; skdT[(d + j) * 8 + i] = kf[j] * dk; } }
    __syncthreads();
    { const int i = wid; const f32x4 qv = *(const LAS f32x4*)(sq + i * 256 + lane * 4);
        for (int j = 0; j < 8; ++j) { const f32x4 kv = *(const LAS f32x4*)(sk + j * 256 + lane * 4);
            float s = wave_sum(qv[0] * kv[0] + qv[1] * kv[1] + qv[2] * kv[2] + qv[3] * kv[3]);
            if (lane == 0) sc[i * 8 + j] = j <= i ? s * exp2f(lg * (float)(i - j)) : 0.f; } }
    const int e4 = lane * 4;
    f32x4 vv[8], oacc[8];
#pragma unroll
    for (int j = 0; j < 8; ++j) { vv[j] = *(const LAS f32x4*)(sv + j * 256 + e4); oacc[j] = (f32x4){0.f, 0.f, 0.f, 0.f}; }
    const float g8 = exp2f(lg * 8.0f);
    const size_t sbase = (((size_t)l * 128 + b) * 8 + h) * 65536;
    const float* Sin = p.state_ret + sbase; float* Sout = pout(p) + O_RS + sbase;
    f32x4 S4[8], N4[8];
#pragma unroll
    for (int u = 0; u < 8; ++u) S4[u] = __builtin_nontemporal_load((const f32x4*)(Sin + (size_t)(wid * 32 + u) * 256 + e4));
#pragma unroll
    for (int dd = 0; dd < 32; dd += 8) {
        const int d0 = launder(wid * 32 + dd);
        const int dn = dd + 8 < 32 ? d0 + 8 : d0;
#pragma unroll
        for (int u = 0; u < 8; ++u) N4[u] = __builtin_nontemporal_load((const f32x4*)(Sin + (size_t)(dn + u) * 256 + e4));
        asm volatile("" ::: "memory");
#pragma unroll
        for (int u = 0; u < 8; ++u) {
            const f32x4 q0 = *(const LAS f32x4*)(sqT + (d0 + u) * 8), q1 = *(const LAS f32x4*)(sqT + (d0 + u) * 8 + 4);
            const f32x4 k0 = *(const LAS f32x4*)(skdT + (d0 + u) * 8), k1 = *(const LAS f32x4*)(skdT + (d0 + u) * 8 + 4);
            f32x4 sn = S4[u] * g8;
            sn += vv[0] * k0[0]; sn += vv[1] * k0[1]; sn += vv[2] * k0[2]; sn += vv[3] * k0[3];
            sn += vv[4] * k1[0]; sn += vv[5] * k1[1]; sn += vv[6] * k1[2]; sn += vv[7] * k1[3];
            *(f32x4*)(Sout + (size_t)(d0 + u) * 256 + e4) = sn;
            oacc[0] += S4[u] * q0[0]; oacc[1] += S4[u] * q0[1]; oacc[2] += S4[u] * q0[2]; oacc[3] += S4[u] * q0[3];
            oacc[4] += S4[u] * q1[0]; oacc[5] += S4[u] * q1[1]; oacc[6] += S4[u] * q1[2]; oacc[7] += S4[u] * q1[3];
        }
        asm volatile("" ::: "memory");
#pragma unroll
        for (int u = 0; u < 8; ++u) S4[u] = N4[u];
    }
#pragma unroll
    for (int i = 0; i < 8; ++i) *(LAS f32x4*)(red + (wid * 8 + i) * 256 + e4) = oacc[i];
    __syncthreads();
    { const int i = wid;
        f32x4 o = (f32x4){0.f, 0.f, 0.f, 0.f};
#pragma unroll
        for (int w = 0; w < 8; ++w) o += *(const LAS f32x4*)(red + (w * 8 + i) * 256 + e4);
        o *= exp2f(lg * (float)(i + 1));
        for (int j = 0; j <= i; ++j) o += *(const LAS f32x4*)(sv + j * 256 + e4) * sc[i * 8 + j];
        const float mu = wave_sum(o[0] + o[1] + o[2] + o[3]) * (1.0f / 256.0f);
        o -= mu;
        const float var = wave_sum(o[0] * o[0] + o[1] * o[1] + o[2] * o[2] + o[3] * o[3]) * (1.0f / 256.0f);
        const float rs = rsqrtf(var + EPS);
        const f32x4 gn = *(const f32x4*)(p.ret_gn + (size_t)l * D + h * 256 + e4);
        const u32x2 rg = *(const u32x2*)(zb + (size_t)(r0 + i) * ZW + ZC_RG + h * 256 + e4);
        u32x2 w; w.x = pk_bf16(o[0] * rs * gn[0] * bf_lo(rg.x), o[1] * rs * gn[1] * bf_hi(rg.x)); w.y = pk_bf16(o[2] * rs * gn[2] * bf_lo(rg.y), o[3] * rs * gn[3] * bf_hi(rg.y));
        *(u32x2*)((bf16_t*)(pws(p) + OFF_AIN) + ((size_t)MPAD + r0 + i) * D + h * 256 + e4) = w; }
    __syncthreads();
}

__device__ __forceinline__ void chunk_geom(int unit, int& b, int& h, int& c, int& n, int& R0, int& slot) {
    int bh; if (unit < 32) { bh = unit; c = 0; } else { bh = (unit - 32) >> 4; c = 1 + ((unit - 32) & 15); }
    b = bh >> 3; h = bh & 7;
    n = c ? 128 : 16; R0 = MS + b * LP + (c ? 16 + 128 * (c - 1) : 0); slot = bh * 17 + c;
}

__device__ void kv_unit(const Params& p, int unit, LAS unsigned char* lds, const int tid_in) {
    const int tid = launder(tid_in); const int wid = __builtin_amdgcn_readfirstlane(tid >> 6);
    int b, h, c, n, R0, slot; chunk_geom(unit, b, h, c, n, R0, slot);
    const float lg = lg2gamma(h);
    const bf16_t* zb = (const bf16_t*)(pws(p) + OFF_ZB) + (size_t)R0 * ZW + h * 256;
    LAS unsigned char* regA = lds; LAS unsigned char* regB = lds + 65536;
    load_tile<true>(regA, zb + ZC_K, ZW, n, lg, tid);
    load_tile<false>(regB, zb + ZC_V, ZW, n, 0.f, tid);
    __syncthreads();
    const int db = (wid >> 1) * 64, ebase = (wid & 1) * 128;
    float* kv = (float*)(pws(p) + OFF_KV) + (size_t)slot * 65536;
    const int nks = n >> 5 ? n >> 5 : 1;
#pragma unroll 1
    for (int pass = 0; pass < 4; ++pass) {
        const int eb = ebase + pass * 32;
        const int lane = launder(tid) & 63;
        f32x4 acc[4][2];
#pragma unroll
        for (int i = 0; i < 4; ++i)
#pragma unroll
            for (int j = 0; j < 2; ++j) acc[i][j] = (f32x4){0.f, 0.f, 0.f, 0.f};
#pragma unroll 1
        for (int ks = 0; ks < nks; ++ks) {
            bf16x8 a[4], bb[2];
#pragma unroll
            for (int i = 0; i < 4; ++i) a[i] = frag_tr(regA, ks * 32, db + i * 16, lane);
#pragma unroll
            for (int j = 0; j < 2; ++j) bb[j] = frag_tr(regB, ks * 32, eb + j * 16, lane);
#pragma unroll
            for (int i = 0; i < 4; ++i)
#pragma unroll
                for (int j = 0; j < 2; ++j) acc[i][j] = __builtin_amdgcn_mfma_f32_16x16x32_bf16(a[i], bb[j], acc[i][j], 0, 0, 0);
        }
        float* kp = kv + (size_t)(db + 4 * (lane >> 4)) * 256 + eb + (lane & 15);
#pragma unroll
        for (int i = 0; i < 4; ++i)
#pragma unroll
            for (int jj = 0; jj < 4; ++jj)
#pragma unroll
                for (int j = 0; j < 2; ++j) kp[(i * 16 + jj) * 256 + j * 16] = acc[i][j][jj];
    }
    __syncthreads();
}

__device__ void pool_item(const Params& p, int l, int item, const int tid_in) {
    const int tid = launder(tid_in);
    const int col = tid * 4, g = tid >> 7, w = 2 << g;
    const float* u = (const float*)(pws(p) + OFF_U);
    bf16_t* pooled = (bf16_t*)(pws(p) + OFF_POOLED);
    f32x4 p_self = (f32x4){0.f, 0.f, 0.f, 0.f}, p_res = p_self, p_hist = p_self;
#pragma unroll 1
    for (int rr = 0; rr <= 16; ++rr) {
        const int row = item * 16 + rr;
        f32x4 self = (f32x4){0.f, 0.f, 0.f, 0.f}, sum = self, hcopy = self; float cnt = 1.f;
        if (rr < 16) {
            self = *(const f32x4*)(u + (size_t)row * D + col); sum = self;
            if (row < MS) {
                const int b = row >> 3, t = row & 7;
                const float* hist = p.state_pool + ((size_t)l * 128 + b) * 15 * D + col;
                for (int i = 1; i < w; ++i) { const int tt = t - i;
                    sum += tt >= 0 ? *(const f32x4*)(u + (size_t)(row - i) * D + col) : *(const f32x4*)(hist + (size_t)(15 + tt) * D); }
                cnt = (float)w;
                if (t < 7) hcopy = *(const f32x4*)(hist + (size_t)(8 + t) * D);
            } else {
                const int pp = (row - MS) % LP;
                for (int i = 1; i < w; ++i) if (pp - i >= 0) sum += *(const f32x4*)(u + (size_t)(row - i) * D + col);
                cnt = (float)(w < pp + 1 ? w : pp + 1);
            }
        }
        asm volatile("" ::: "memory");
        if (rr > 0) {
            const int prow = row - 1;
            u32x2 o; o.x = pk_bf16(p_res[0], p_res[1]); o.y = pk_bf16(p_res[2], p_res[3]);
            *(u32x2*)(pooled + (size_t)prow * D + col) = o;
            if (prow < MS) {
                const int b = prow >> 3, t = prow & 7;
                float* np = pout(p) + O_PS + ((size_t)l * 128 + b) * 15 * D + col;
                *(f32x4*)(np + (size_t)(7 + t) * D) = p_self;
                if (t < 7) *(f32x4*)(np + (size_t)t * D) = p_hist;
            } else {
                const int pr = prow - MS, b = pr / LP, pp = pr % LP;
                if (pp >= 2049) *(f32x4*)(pout(p) + O_PP + (((size_t)l * 4 + b) * 15 + (pp - 2049)) * D + col) = p_self;
            }
        }
        asm volatile("" ::: "memory");
        p_res = sum * (1.0f / cnt) - self; p_self = self; p_hist = hcopy;
    }
}

__device__ void scan_item2(const Params& p, int l, int itemA, int itemB, const int tid_in) {
    const int tid = launder(tid_in);
    const int bhA = itemA >> 5, eA = ((itemA & 31) * 512 + tid) * 4, bhB = itemB >> 5, eB = ((itemB & 31) * 512 + tid) * 4;
    const float dA = exp2f(lg2gamma(bhA & 7) * 128.0f), dB = exp2f(lg2gamma(bhB & 7) * 128.0f);
    const float* kvA = (const float*)(pws(p) + OFF_KV) + (size_t)bhA * 17 * 65536 + eA;
    const float* kvB = (const float*)(pws(p) + OFF_KV) + (size_t)bhB * 17 * 65536 + eB;
    bf16_t* sbA = (bf16_t*)(pws(p) + OFF_SB) + (size_t)bhA * 17 * 65536 + eA;
    bf16_t* sbB = (bf16_t*)(pws(p) + OFF_SB) + (size_t)bhB * 17 * 65536 + eB;
    f32x4 ka[17], kb[17];
#pragma unroll
    for (int c = 0; c < 17; ++c) { ka[c] = __builtin_nontemporal_load((const f32x4*)(kvA + (size_t)c * 65536)); kb[c] = __builtin_nontemporal_load((const f32x4*)(kvB + (size_t)c * 65536)); }
    asm volatile("" ::: "memory");
    f32x4 SA = ka[0], SB = kb[0];
#pragma unroll
    for (int c = 1; c < 17; ++c) {
        u32x2 w; w.x = pk_bf16(SA[0], SA[1]); w.y = pk_bf16(SA[2], SA[3]);
        *(u32x2*)(sbA + (size_t)c * 65536) = w;
        w.x = pk_bf16(SB[0], SB[1]); w.y = pk_bf16(SB[2], SB[3]);
        *(u32x2*)(sbB + (size_t)c * 65536) = w;
        SA = SA * dA + ka[c]; SB = SB * dB + kb[c];
    }
    *(f32x4*)(pout(p) + O_RP + ((size_t)l * 32 + bhA) * 65536 + eA) = SA;
    *(f32x4*)(pout(p) + O_RP + ((size_t)l * 32 + bhB) * 65536 + eB) = SB;
}

__device__ void ret_out_unit(const Params& p, int l, int unit, LAS unsigned char* lds, const int tid_in) {
    const int tid = launder(tid_in); const int wid = __builtin_amdgcn_readfirstlane(tid >> 6);
    int b, h, c, n, R0, slot; chunk_geom(unit, b, h, c, n, R0, slot);
    const float lg = lg2gamma(h);
    const bf16_t* zb = (const bf16_t*)(pws(p) + OFF_ZB) + (size_t)R0 * ZW + h * 256;
    LAS unsigned char* regA = lds; LAS unsigned char* regB = lds + 65536;
    load_tile<false>(regA, zb + ZC_Q, ZW, n, 0.f, tid);
    load_tile<false>(regB, zb + ZC_K, ZW, n, 0.f, tid);
    __syncthreads();
    const int jb = (wid & 3) * 32, ib = (wid >> 2) * 64;
    u32x2 pk[2][4];
    {
        const int lane = launder(tid) & 63, g = lane >> 4, lc = lane & 15;
        f32x4 sc[2][4];
#pragma unroll
        for (int i = 0; i < 2; ++i)
#pragma unroll
            for (int j = 0; j < 4; ++j) sc[i][j] = (f32x4){0.f, 0.f, 0.f, 0.f};
#pragma unroll 1
        for (int ks = 0; ks < 8; ++ks) {
            bf16x8 a[2], bq[4];
#pragma unroll
            for (int i = 0; i < 2; ++i) a[i] = frag_direct(regB, jb + i * 16, ks * 32, lane);
#pragma unroll
            for (int j = 0; j < 4; ++j) bq[j] = frag_direct(regA, ib + j * 16, ks * 32, lane);
#pragma unroll
            for (int i = 0; i < 2; ++i)
#pragma unroll
                for (int j = 0; j < 4; ++j) sc[i][j] = __builtin_amdgcn_mfma_f32_16x16x32_bf16(a[i], bq[j], sc[i][j], 0, 0, 0);
        }
#pragma unroll
        for (int i = 0; i < 2; ++i)
#pragma unroll
            for (int j = 0; j < 4; ++j) {
                const int ii = ib + j * 16 + lc; float v[4];
#pragma unroll
                for (int jj = 0; jj < 4; ++jj) { const int jx = jb + i * 16 + 4 * g + jj; v[jj] = jx <= ii ? sc[i][j][jj] * exp2f(lg * (float)(ii - jx)) : 0.f; }
                pk[i][j].x = pk_bf16(v[0], v[1]); pk[i][j].y = pk_bf16(v[2], v[3]);
            }
    }
    const int ib2 = (wid >> 1) * 32, eb = (wid & 1) * 128;
    f32x4 acc[2][8];
#pragma unroll
    for (int i = 0; i < 2; ++i)
#pragma unroll
        for (int j = 0; j < 8; ++j) acc[i][j] = (f32x4){0.f, 0.f, 0.f, 0.f};
    if (c > 0) {
        const int lane = launder(tid) & 63, g = lane >> 4;
        const bf16_t* sb = (const bf16_t*)(pws(p) + OFF_SB) + (size_t)slot * 65536;
#pragma unroll 1
        for (int half = 0; half < 2; ++half) {
            __syncthreads();
            load_tile<false>(regB, sb + (size_t)half * 128 * 256, 256, 128, 0.f, tid);
            __syncthreads();
#pragma unroll 1
            for (int ks = 0; ks < 4; ++ks) {
                bf16x8 a[2];
#pragma unroll
                for (int i = 0; i < 2; ++i) a[i] = frag_direct(regA, ib2 + i * 16, half * 128 + ks * 32, lane);
#pragma unroll
                for (int j = 0; j < 8; ++j) { const bf16x8 bs = frag_tr(regB, ks * 32, eb + j * 16, lane);
#pragma unroll
                    for (int i = 0; i < 2; ++i) acc[i][j] = __builtin_amdgcn_mfma_f32_16x16x32_bf16(a[i], bs, acc[i][j], 0, 0, 0); }
            }
        }
#pragma unroll
        for (int i = 0; i < 2; ++i)
#pragma unroll
            for (int jj = 0; jj < 4; ++jj) { const float f = exp2f(lg * (float)(ib2 + i * 16 + 4 * g + jj + 1));
#pragma unroll
                for (int j = 0; j < 8; ++j) acc[i][j][jj] *= f; }
    }
    __syncthreads();
    { const int lane = launder(tid) & 63, g = lane >> 4, lc = lane & 15;
#pragma unroll
    for (int i = 0; i < 2; ++i)
#pragma unroll
        for (int j = 0; j < 4; ++j) *(LAS u32x2*)(regA + img_off(ib + j * 16 + lc, jb + i * 16 + 4 * g)) = pk[i][j]; }
    load_tile<false>(regB, zb + ZC_V, ZW, n, 0.f, tid);
    __syncthreads();
    const int ksmax = (ib2 + 31) >> 5;
    { const int lane = launder(tid) & 63;
#pragma unroll 1
    for (int ks = 0; ks <= ksmax; ++ks) {
        bf16x8 a[2];
#pragma unroll
        for (int i = 0; i < 2; ++i) a[i] = frag_direct(regA, ib2 + i * 16, ks * 32, lane);
#pragma unroll
        for (int j = 0; j < 8; ++j) { const bf16x8 bs = frag_tr(regB, ks * 32, eb + j * 16, lane);
#pragma unroll
            for (int i = 0; i < 2; ++i) acc[i][j] = __builtin_amdgcn_mfma_f32_16x16x32_bf16(a[i], bs, acc[i][j], 0, 0, 0); }
    } }
    __syncthreads();
    LAS float* oL = (LAS float*)lds;
    { const int lane = launder(tid) & 63, g = lane >> 4, lc = lane & 15;
#pragma unroll
    for (int i = 0; i < 2; ++i)
#pragma unroll
        for (int j = 0; j < 8; ++j)
#pragma unroll
            for (int jj = 0; jj < 4; ++jj) oL[(ib2 + i * 16 + 4 * g + jj) * 260 + eb + j * 16 + lc] = acc[i][j][jj]; }
    __syncthreads();
    const int lane = launder(tid) & 63;
    const f32x4 gn = *(const f32x4*)(p.ret_gn + (size_t)l * D + h * 256 + lane * 4);
    u32x2 rgv[16];
#pragma unroll
    for (int rr = 0; rr < 16; ++rr) { const int i = wid * 16 + rr; rgv[rr] = (u32x2){0u, 0u};
        if (i < n) rgv[rr] = *(const u32x2*)(zb + (size_t)i * ZW + ZC_RG + lane * 4); }
    asm volatile("" ::: "memory");
#pragma unroll
    for (int rr = 0; rr < 16; ++rr) {
        const int i = wid * 16 + rr;
        if (i < n) {
            f32x4 o = *(const LAS f32x4*)(oL + i * 260 + lane * 4);
            const float mu = wave_sum(o[0] + o[1] + o[2] + o[3]) * (1.0f / 256.0f);
            o -= mu;
            const float var = wave_sum(o[0] * o[0] + o[1] * o[1] + o[2] * o[2] + o[3] * o[3]) * (1.0f / 256.0f);
            const float rs = rsqrtf(var + EPS);
            const u32x2 rg = rgv[rr];
            u32x2 w; w.x = pk_bf16(o[0] * rs * gn[0] * bf_lo(rg.x), o[1] * rs * gn[1] * bf_hi(rg.x)); w.y = pk_bf16(o[2] * rs * gn[2] * bf_lo(rg.y), o[3] * rs * gn[3] * bf_hi(rg.y));
            *(u32x2*)((bf16_t*)(pws(p) + OFF_AIN) + ((size_t)MPAD + R0 + i) * D + h * 256 + lane * 4) = w;
        }
    }
    __syncthreads();
}

__device__ __forceinline__ float* final_dst(const Params& p, int row) {
    if (row < MS) return pout(p) + O_YS + (size_t)row * D;
    const int pr = row - MS, b = pr / LP, pp = pr % LP;
    return pp < 16 ? nullptr : pout(p) + O_YP + ((size_t)b * 2048 + pp - 16) * D;
}
__device__ void final_item(const Params& p, int item, const int tid_in) {
    const int tid = launder(tid_in);
    const int wid = tid >> 6, lane = tid & 63, r0 = item * 16 + wid, r1 = r0 + 8;
    float* d0 = final_dst(p, r0); float* d1 = final_dst(p, r1);
    const float* x0 = (const float*)(pws(p) + OFF_XF) + (size_t)r0 * D; const float* x1 = x0 + (size_t)8 * D;
    f32x4 v0[8], v1[8]; float s0 = 0.f, s1 = 0.f;
#pragma unroll
    for (int i = 0; i < 8; ++i) { v0[i] = *(const f32x4*)(x0 + i * 256 + lane * 4); v1[i] = *(const f32x4*)(x1 + i * 256 + lane * 4); }
#pragma unroll
    for (int i = 0; i < 8; ++i) { s0 += v0[i][0] * v0[i][0] + v0[i][1] * v0[i][1] + v0[i][2] * v0[i][2] + v0[i][3] * v0[i][3];
        s1 += v1[i][0] * v1[i][0] + v1[i][1] * v1[i][1] + v1[i][2] * v1[i][2] + v1[i][3] * v1[i][3]; }
    const float rs0 = rsqrtf(wave_sum(s0) * (1.0f / 2048.0f) + EPS), rs1 = rsqrtf(wave_sum(s1) * (1.0f / 2048.0f) + EPS);
#pragma unroll
    for (int i = 0; i < 8; ++i) { const f32x4 gg = *(const f32x4*)(p.final_norm + i * 256 + lane * 4);
        if (d0) *(f32x4*)(d0 + i * 256 + lane * 4) = v0[i] * rs0 * gg;
        if (d1) *(f32x4*)(d1 + i * 256 + lane * 4) = v1[i] * rs1 * gg; }
}

#ifndef PH_MASK
#define PH_MASK 0xff
#endif
__device__ __forceinline__ void run_phase(const Params& p, int ph, LAS unsigned char* lds, const int tid, const int bid) {
    const int G = gridDim.x;
    if (ph == 0) { if (PH_MASK & 1) phase0(p, lds, tid, bid); return; }
    if (ph == 13) { if (PH_MASK & 128) for (int it = bid; it < MR / 16; it += G) final_item(p, it, tid); return; }
    const int l = (ph - 1) / 6, sub = (ph - 1) % 6;
    if (sub == 0) { if (PH_MASK & 2) {
        SchedPlain S; S.init(MPAD, NIN, G, bid); S.A = pws(p) + OFF_XB; S.Bt = pws(p) + OFF_WIN + l * SZ_WIN; S.tstepA = (size_t)256 * D * 2; S.tstepB = (size_t)256 * D * 2;
        EpiWin E; E.u = (float*)(pws(p) + OFF_U); E.zb = (bf16_t*)(pws(p) + OFF_ZB); E.rsq = (const float*)(pws(p) + OFF_RSQ) + (size_t)l * MPAD; E.cf = (const float*)(pws(p) + OFF_CS);
        gemm_phase(lds, S, E, D, D, D, tid); }
    } else if (sub == 1) { if (PH_MASK & 4)
        for (int it = bid; it < 1024 + 544 + 580; it += G) {
            if (it < 1024) sample_ret_unit(p, l, it, lds, tid);
            else if (it < 1568) kv_unit(p, it - 1024, lds, tid);
            else pool_item(p, l, it - 1568, tid);
        }
    } else if (sub == 2) { if (PH_MASK & 8) {
        for (int it = bid; it + G < 1024; it += 2 * G) scan_item2(p, l, it, it + G, tid); }
    } else if (sub == 3) { if (PH_MASK & 16) {
        SchedPool S; S.init(MPAD, D, G, (bid + 128) % G); S.A = pws(p) + OFF_POOLED; S.Bt = pws(p) + OFF_WPOOL + l * SZ_WPOOL;
        EpiPool E; E.ain = (bf16_t*)(pws(p) + OFF_AIN); E.zb = (const bf16_t*)(pws(p) + OFF_ZB);
        gemm_phase(lds, S, E, 512, D, 512, tid);
        for (int it = bid; it < 544; it += G) ret_out_unit(p, l, it, lds, launder(tid)); }
    } else if (sub == 4) { if (PH_MASK & 32) {
        SchedDual S; S.init(MPAD, D, G, bid); S.A = pws(p) + OFF_AIN; S.Bt = pws(p) + OFF_WPR + l * SZ_WPR;
        EpiDual E; E.merged = (bf16_t*)(pws(p) + OFF_MERGED); E.zb = (const bf16_t*)(pws(p) + OFF_ZB);
        { const int sidx = bid < 40 ? bid : (bid < 80 ? bid - 40 : 0); E.m1 = (float*)(pws(p) + OFF_M1) + ((size_t)l * 40 + sidx) * 65536; E.flag = (unsigned*)(pws(p) + OFF_BAR + 16384) + (l * 40 + sidx) * 64; }
        gemm_phase(lds, S, E, D, D, D, tid);
        if (l == 0 && bid >= 80) for (int it = bid - 80; it < 1440; it += G - 80) conv_item(p, 1, it, lds, launder(tid)); }
    } else { if (PH_MASK & 64) {
        SchedPlain S; S.init(MPAD, D, G, bid); S.A = pws(p) + OFF_MERGED; S.Bt = pws(p) + OFF_WOUT + l * SZ_WOUT; S.tstepA = (size_t)256 * D * 2; S.tstepB = (size_t)256 * D * 2;
        EpiOut E; E.xf = (float*)(pws(p) + OFF_XF); E.xb = (bf16_t*)(pws(p) + OFF_XB); E.rsq_next = l == 0 ? (float*)(pws(p) + OFF_RSQ) + MPAD : nullptr;
        gemm_phase(lds, S, E, D, D, D, tid);
        if (l == 0 && bid >= 40) for (int it = 1440 + bid - 40; it < 2880; it += G - 40) conv_item(p, 1, it, lds, launder(tid)); }
    }
}

#define XB_TMO      128
#define XB_XCNT(j)  (256  + 64 * (j))
#define XB_XSUB(j)  (1280 + 64 * (j))
#define XB_XGEN(j)  (2304 + 64 * (j))
#define XB_TOP      3328
#define XB_TOPGEN   3392
#define XCD_BAR_WORDS 3456
#define XB_SPIN_CAP (1u << 18)
__device__ __forceinline__ unsigned xb_ld(unsigned* p)              { return __hip_atomic_load(p, __ATOMIC_RELAXED, __HIP_MEMORY_SCOPE_AGENT); }
__device__ __forceinline__ unsigned xb_add(unsigned* p, unsigned v) { return __hip_atomic_fetch_add(p, v, __ATOMIC_RELAXED, __HIP_MEMORY_SCOPE_AGENT); }
__device__ __forceinline__ unsigned xb_xcc_id() { return (unsigned)__builtin_amdgcn_s_getreg((3 << 11) | 20) & 0xFu; }
#define XB_SPIN(cond, bar) do { unsigned _sp = 0; while (cond) { __builtin_amdgcn_s_sleep(1); \
    if ((++_sp & 255u) == 0u) { if (xb_ld(&(bar)[XB_TMO])) break; if (_sp > XB_SPIN_CAP) { atomicAdd(&(bar)[XB_TMO], 1u); break; } } } } while (0)
struct XcdBarrier { unsigned* bar; unsigned x; volatile LAS unsigned* st; };
__device__ __forceinline__ XcdBarrier xcd_barrier_post(unsigned* bar, volatile LAS unsigned* st) {
    XcdBarrier b; b.bar = bar; b.x = xb_xcc_id(); b.st = st;
    if (threadIdx.x == 0) (void)xb_add(&bar[XB_XCNT(b.x)], 1u);
    return b;
}
__device__ __forceinline__ void xcd_barrier_complete(unsigned* bar, unsigned x, unsigned& nloc, unsigned& nx) {
    const unsigned G = gridDim.x * gridDim.y * gridDim.z;
    unsigned sum, cnt, mine, sp = 0u;
    for (;;) {
        sum = 0u; cnt = 0u; mine = 0u;
#pragma unroll
        for (unsigned j = 0; j < 16; ++j) { const unsigned c = xb_ld(&bar[XB_XCNT(j)]); sum += c; cnt += (c > 0u) ? 1u : 0u; mine = (j == x) ? c : mine; }
        if (sum == G) break;
        __builtin_amdgcn_s_sleep(1);
        if ((++sp & 255u) == 0u) { if (xb_ld(&bar[XB_TMO])) break; if (sp > XB_SPIN_CAP) { atomicAdd(&bar[XB_TMO], 1u); break; } }
    }
    nloc = mine > 0u ? mine : 1u; nx = cnt > 0u ? cnt : 1u;
}
__device__ __forceinline__ void xcd_barrier(unsigned* bar_in, LAS unsigned char* lds_in) {
    XcdBarrier b; b.bar = bar_in; b.x = xb_xcc_id(); b.st = (volatile LAS unsigned*)(lds_in + LDS_ST_OFF);
    asm volatile("s_waitcnt vmcnt(0)" ::: "memory");
    __syncthreads();
    if (threadIdx.x == 0) {
        unsigned* bar = b.bar;
        __builtin_amdgcn_s_waitcnt(0);
        unsigned nloc = b.st[0], nx = b.st[1];
        if (nloc == 0u) { xcd_barrier_complete(bar, b.x, nloc, nx); b.st[0] = nloc; b.st[1] = nx; }
        const unsigned old = xb_add(&bar[XB_XSUB(b.x)], 1u);
        const unsigned gen = old / nloc;
        if (old + 1u == (gen + 1u) * nloc) {
            __builtin_amdgcn_fence(__ATOMIC_RELEASE, "agent");
            asm volatile("s_waitcnt vmcnt(0)" ::: "memory");
            const unsigned og = xb_add(&bar[XB_TOP], 1u);
            const unsigned tg = og / nx;
            if (og + 1u == (tg + 1u) * nx) xb_add(&bar[XB_TOPGEN], 1u);
            else XB_SPIN(xb_ld(&bar[XB_TOPGEN]) == tg, bar);
            __builtin_amdgcn_fence(__ATOMIC_ACQUIRE, "agent");
            xb_add(&bar[XB_XGEN(b.x)], 1u);
            asm volatile("s_waitcnt vmcnt(0)" ::: "memory");
        } else {
            XB_SPIN(xb_ld(&bar[XB_XGEN(b.x)]) == gen, bar);
            __builtin_amdgcn_fence(__ATOMIC_ACQUIRE, "agent");
            asm volatile("s_waitcnt vmcnt(0)" ::: "memory");
        }
    }
    __syncthreads();
}

extern __shared__ __attribute__((aligned(16))) unsigned char smem_dyn[];

#if MULTI
__global__ void __launch_bounds__(512, 2) phase_kernel(Params p, int ph) {
    int tid = threadIdx.x; asm volatile("" : "+v"(tid));
    int bid = blockIdx.x; asm volatile("" : "+s"(bid));
    run_phase(p, ph, (LAS unsigned char*)smem_dyn, tid, bid);
}
#else
__global__ void __launch_bounds__(512, 2) mega_kernel(Params p, unsigned* bar) {
    cg::grid_group grid = cg::this_grid();
    LAS unsigned char* lds = (LAS unsigned char*)smem_dyn;
#ifndef REPEAT_SUB
#define REPEAT_SUB -1
#endif
    volatile LAS unsigned* st = (volatile LAS unsigned*)(lds + LDS_ST_OFF);
    if (threadIdx.x == 0) { st[0] = 0u; st[1] = 0u; }
    __syncthreads();
    (void)xcd_barrier_post(bar, st);
    int ph = 0, rep = 0;
#pragma unroll 1
    while (ph < 14) {
        int tid = threadIdx.x; asm volatile("" : "+v"(tid));
        int bid = blockIdx.x; asm volatile("" : "+s"(bid)); bid = __builtin_amdgcn_readfirstlane(bid);
        run_phase(p, ph, lds, tid, bid);
        if (ph == 0) grid.sync(); else if (ph < 13) xcd_barrier(bar, lds);
        const bool match = (REPEAT_SUB == 100) ? (ph == 0) : (ph >= 1 && ph <= 12 && ((ph - 1) % 6) == REPEAT_SUB);
        if (match && rep == 0) rep = 1; else { rep = 0; ++ph; }
    }
}
#endif

extern "C" void kernel_launch(void* const* d_in, const int* in_sizes, int n_in, void* d_out, int out_size, void* d_ws, size_t ws_size, hipStream_t stream) {
    Params p{};
    p.x_prompt = (const float*)d_in[0]; p.x_sample = (const float*)d_in[1]; p.state_pool = (const float*)d_in[2]; p.state_ret = (const float*)d_in[3];
    p.meta = (const float*)d_in[4]; p.norm_gain = (const float*)d_in[5]; p.w_in = (const float*)d_in[6]; p.pool_w = (const float*)d_in[7];
    p.pool_scale = (const float*)d_in[8]; p.ret_gn = (const float*)d_in[9]; p.proj_pool = (const float*)d_in[10]; p.proj_ret = (const float*)d_in[11];
    p.w_out = (const float*)d_in[12]; p.final_norm = (const float*)d_in[13];
    p.out = (float*)d_out; p.ws = (char*)d_ws;
    if (ws_size < WS_TOTAL) { fprintf(stderr, "workspace too small: %zu < %zu\n", ws_size, (size_t)WS_TOTAL); return; }
#if MULTI
    static bool attr_set = false;
    if (!attr_set) { hipFuncSetAttribute((const void*)phase_kernel, hipFuncAttributeMaxDynamicSharedMemorySize, LDS_BYTES); attr_set = true; }
    for (int ph = 0; ph < 14; ++ph) phase_kernel<<<dim3(256), dim3(512), LDS_BYTES, stream>>>(p, ph);
#else
    static int grid_blocks = 0;
    if (!grid_blocks) {
        hipFuncSetAttribute((const void*)mega_kernel, hipFuncAttributeMaxDynamicSharedMemorySize, LDS_BYTES);
        int dev = 0, cus = 0, per_cu = 0;
        hipGetDevice(&dev);
        hipDeviceGetAttribute(&cus, hipDeviceAttributeMultiprocessorCount, dev);
        hipOccupancyMaxActiveBlocksPerMultiprocessor(&per_cu, mega_kernel, 512, LDS_BYTES);
        if (per_cu > 1) per_cu = 1;
        grid_blocks = cus * per_cu;
    }
    (void)hipMemsetAsync((char*)d_ws + OFF_BAR, 0, 16384 + 32768, stream);
    unsigned* bar = (unsigned*)((char*)d_ws + OFF_BAR);
    void* args[] = {&p, &bar};
    hipError_t e = hipLaunchCooperativeKernel((void*)mega_kernel, dim3(grid_blocks), dim3(512), args, LDS_BYTES, stream);
    if (e != hipSuccess) fprintf(stderr, "cooperative launch failed: %s (grid %d)\n", hipGetErrorString(e), grid_blocks);
#endif
}
```
